# Optimizing an MI355X kernel written in HIP

```python
import jax, jax.numpy as jnp
from jax import lax
import numpy as np

D_MODEL = 2048
BATCH = 4
SEQ = 4096
DEPTH = 1

N_MEM = 256
D_MIX = D_MODEL
MLA_HEADS = 8
MLA_NOPE = 128
MLA_ROPE = 64
MLA_V = 128
Q_LORA = 512
KV_LORA = 512
GMLP_GROUPS = 4
GMLP_CH = 128
CHUNK = 128
MEM_HEADS = 4
MEM_HEAD_DIM = 128
MLA_WIDTH = MLA_HEADS * MLA_V
GMLP_WIDTH = GMLP_GROUPS * GMLP_CH
MEM_WIDTH = MEM_HEADS * MEM_HEAD_DIM
IN_COLS = Q_LORA + KV_LORA + MLA_ROPE + 2 * GMLP_WIDTH + MEM_WIDTH
N_EXPERTS = 32
TOP_K = 4
D_EXPERT = D_MODEL
SWIGLU_ALPHA = 1.702
SWIGLU_LIMIT = 7.0
MOE_BLOCK = 256
Q_BLOCK = 128
ROPE_BASE = 10000.0
EPS = 1e-6

kernel_name = 'hybrid_mla_gmlp_memxattn_moe'


def rms_norm(x, g):
    xf = x.astype(jnp.float32)
    y = xf * lax.rsqrt(jnp.mean(xf * xf, axis=-1, keepdims=True) + EPS)
    return (y * g.astype(jnp.float32)).astype(x.dtype)


def apply_rope(x, positions):
    half = x.shape[-1] // 2
    inv_freq = ROPE_BASE ** (-jnp.arange(half, dtype=jnp.float32) / half)
    ang = positions.astype(jnp.float32)[:, :, None, None] * inv_freq
    cos, sin = jnp.cos(ang), jnp.sin(ang)
    xf = x.astype(jnp.float32)
    x1, x2 = xf[..., :half], xf[..., half:]
    return jnp.concatenate([x1 * cos - x2 * sin, x1 * sin + x2 * cos], axis=-1).astype(x.dtype)


def causal_block_attention(q, k, v):
    B, S, H, Dk = q.shape
    Dv = v.shape[-1]
    nb = S // Q_BLOCK
    qb = q.reshape(B, nb, Q_BLOCK, H, Dk).transpose(1, 0, 2, 3, 4)
    scale = Dk ** -0.5
    kpos = jnp.arange(S)

    def one_block(args):
        qi, i = args
        s = jnp.einsum('bqhd,bkhd->bhqk', qi, k).astype(jnp.float32) * scale
        qpos = i * Q_BLOCK + jnp.arange(Q_BLOCK)
        s = jnp.where(kpos[None, :] <= qpos[:, None], s, -jnp.inf)
        p = jax.nn.softmax(s, axis=-1).astype(v.dtype)
        return jnp.einsum('bhqk,bkhd->bqhd', p, v)

    o = lax.map(one_block, (qb, jnp.arange(nb)))
    return o.transpose(1, 0, 2, 3, 4).reshape(B, S, H, Dv)


def token_mixers(h, mem, positions, w_in, q_a_norm, w_q_b, kv_a_norm, w_kv_b,
                 q_nope_norm, q_rope_norm, k_nope_norm, k_rope_norm,
                 gmlp_v_norm, w_spatial, b_spatial,
                 mem_norm, w_mem_kv, mem_q_norm, mem_k_norm,
                 mla_out_norm, gmlp_out_norm, mem_out_norm, w_o):
    B, S, _ = h.shape
    z = h @ w_in
    o1 = Q_LORA
    o2 = o1 + KV_LORA
    o3 = o2 + MLA_ROPE
    o4 = o3 + 2 * GMLP_WIDTH
    c_q, c_kv, k_rope, g_in, q_mem = z[..., :o1], z[..., o1:o2], z[..., o2:o3], z[..., o3:o4], z[..., o4:]

    q = (rms_norm(c_q, q_a_norm) @ w_q_b).reshape(B, S, MLA_HEADS, MLA_NOPE + MLA_ROPE)
    q_nope = rms_norm(q[..., :MLA_NOPE], q_nope_norm)
    q_pe = apply_rope(rms_norm(q[..., MLA_NOPE:], q_rope_norm), positions)
    kv = (rms_norm(c_kv, kv_a_norm) @ w_kv_b).reshape(B, S, MLA_HEADS, MLA_NOPE + MLA_V)
    k_nope = rms_norm(kv[..., :MLA_NOPE], k_nope_norm)
    v = kv[..., MLA_NOPE:]
    k_pe = apply_rope(rms_norm(k_rope, k_rope_norm)[:, :, None, :], positions)
    k = jnp.concatenate([k_nope, jnp.broadcast_to(k_pe, (B, S, MLA_HEADS, MLA_ROPE))], axis=-1)
    qf = jnp.concatenate([q_nope, q_pe], axis=-1)
    o_mla = causal_block_attention(qf, k, v).reshape(B, S, MLA_WIDTH)

    g = jax.nn.gelu(g_in, approximate=False)
    u, vg = g[..., :GMLP_WIDTH], g[..., GMLP_WIDTH:]
    vg = rms_norm(vg, gmlp_v_norm).reshape(B, S // CHUNK, CHUNK, GMLP_GROUPS, GMLP_CH)
    causal = jnp.tril(jnp.ones((CHUNK, CHUNK), dtype=bool))
    ws = jnp.where(causal[None], w_spatial, jnp.zeros_like(w_spatial))
    sp = jnp.einsum('gts,bnsgc->bntgc', ws, vg) + b_spatial.T[None, None, :, :, None]
    o_gmlp = u * sp.reshape(B, S, GMLP_WIDTH)

    M = mem.shape[1]
    mkv = (rms_norm(mem, mem_norm) @ w_mem_kv).reshape(B, M, 2, MEM_HEADS, MEM_HEAD_DIM)
    mk = rms_norm(mkv[:, :, 0], mem_k_norm)
    mv = mkv[:, :, 1]
    mq = rms_norm(q_mem.reshape(B, S, MEM_HEADS, MEM_HEAD_DIM), mem_q_norm)
    s = jnp.einsum('bshd,bmhd->bhsm', mq, mk).astype(jnp.float32) * (MEM_HEAD_DIM ** -0.5)
    p = jax.nn.softmax(s, axis=-1).astype(mv.dtype)
    o_mem = jnp.einsum('bhsm,bmhd->bshd', p, mv).reshape(B, S, MEM_WIDTH)

    o = jnp.concatenate([rms_norm(o_mla, mla_out_norm),
                         rms_norm(o_gmlp, gmlp_out_norm),
                         rms_norm(o_mem, mem_out_norm)], axis=-1)
    return o @ w_o


def moe_ffn(h, w_router, b_router, w_gate_up, b_gate_up, w_down, b_down):
    B, S, D = h.shape
    xt = h.reshape(-1, D)
    N = xt.shape[0]
    logits = (xt @ w_router + b_router).astype(jnp.float32)
    top_val, top_idx = lax.top_k(logits, TOP_K)
    gates = jax.nn.softmax(top_val, axis=-1)
    NK = N * TOP_K
    e_flat = top_idx.reshape(-1).astype(jnp.int32)
    g_flat = gates.reshape(-1).astype(h.dtype)
    tok_flat = jnp.arange(NK, dtype=jnp.int32) // TOP_K
    order = jnp.argsort(e_flat)
    e_sorted = e_flat[order]
    counts = jnp.bincount(e_flat, length=N_EXPERTS).astype(jnp.int32)
    padded = ((counts + MOE_BLOCK - 1) // MOE_BLOCK) * MOE_BLOCK
    start = jnp.cumsum(counts) - counts
    pend = jnp.cumsum(padded)
    pstart = pend - padded
    dest = pstart[e_sorted] + jnp.arange(NK, dtype=jnp.int32) - start[e_sorted]
    n_blocks = -(-(NK + N_EXPERTS * (MOE_BLOCK - 1)) // MOE_BLOCK)
    P = n_blocks * MOE_BLOCK
    row_tok = jnp.zeros((P,), jnp.int32).at[dest].set(tok_flat[order])
    row_gate = jnp.zeros((P,), h.dtype).at[dest].set(g_flat[order])
    block_exp = jnp.minimum(
        jnp.searchsorted(pend, jnp.arange(n_blocks, dtype=jnp.int32) * MOE_BLOCK, side='right'),
        N_EXPERTS - 1)

    def expert_block(args):
        toks, e = args
        xb = xt[toks]
        gu = xb @ w_gate_up[e] + b_gate_up[e]
        gate = jnp.minimum(gu[:, :D_EXPERT], SWIGLU_LIMIT)
        up = jnp.clip(gu[:, D_EXPERT:], -SWIGLU_LIMIT, SWIGLU_LIMIT)
        act = (up + 1.0) * (gate * jax.nn.sigmoid(SWIGLU_ALPHA * gate))
        return act @ w_down[e] + b_down[e]

    y = lax.map(expert_block, (row_tok.reshape(n_blocks, MOE_BLOCK), block_exp))
    y = y.reshape(P, D) * row_gate[:, None]
    out = jnp.zeros((N, D), y.dtype).at[row_tok].add(y)
    return out.reshape(B, S, D)


def setup_inputs(seed: int = 0) -> dict:
    key = jax.random.key(seed)
    ks = jax.random.split(key, 40)
    L = DEPTH
    f32 = jnp.float32

    def nrm(k, shape, scale):
        return jax.random.normal(k, shape, f32) * scale

    def gain(k, shape):
        return 1.0 + 0.02 * jax.random.normal(k, shape, f32)

    x = jax.random.normal(ks[0], (BATCH, SEQ, D_MODEL), f32)
    mem = jax.random.normal(ks[1], (BATCH, N_MEM, D_MODEL), f32)
    offsets = jax.random.randint(ks[2], (BATCH, 1), 0, 1024, dtype=jnp.int32)
    positions = offsets + jnp.arange(SEQ, dtype=jnp.int32)[None, :]
    return {
        'x': x,
        'mem': mem,
        'positions': positions,
        'attn_norm': gain(ks[3], (L, D_MODEL)),
        'w_in': nrm(ks[4], (L, D_MODEL, IN_COLS), D_MODEL ** -0.5),
        'q_a_norm': gain(ks[5], (L, Q_LORA)),
        'w_q_b': nrm(ks[6], (L, Q_LORA, MLA_HEADS * (MLA_NOPE + MLA_ROPE)), Q_LORA ** -0.5),
        'kv_a_norm': gain(ks[7], (L, KV_LORA)),
        'w_kv_b': nrm(ks[8], (L, KV_LORA, MLA_HEADS * (MLA_NOPE + MLA_V)), KV_LORA ** -0.5),
        'q_nope_norm': gain(ks[9], (L, MLA_NOPE)),
        'q_rope_norm': gain(ks[10], (L, MLA_ROPE)),
        'k_nope_norm': gain(ks[11], (L, MLA_NOPE)),
        'k_rope_norm': gain(ks[12], (L, MLA_ROPE)),
        'gmlp_v_norm': gain(ks[13], (L, GMLP_WIDTH)),
        'w_spatial': nrm(ks[14], (L, GMLP_GROUPS, CHUNK, CHUNK), 0.5 * CHUNK ** -0.5),
        'b_spatial': 1.0 + 0.01 * jax.random.normal(ks[15], (L, GMLP_GROUPS, CHUNK), f32),
        'mem_norm': gain(ks[16], (L, D_MODEL)),
        'w_mem_kv': nrm(ks[17], (L, D_MODEL, 2 * MEM_WIDTH), D_MODEL ** -0.5),
        'mem_q_norm': gain(ks[18], (L, MEM_HEAD_DIM)),
        'mem_k_norm': gain(ks[19], (L, MEM_HEAD_DIM)),
        'mla_out_norm': gain(ks[20], (L, MLA_WIDTH)),
        'gmlp_out_norm': gain(ks[21], (L, GMLP_WIDTH)),
        'mem_out_norm': gain(ks[22], (L, MEM_WIDTH)),
        'w_o': nrm(ks[23], (L, D_MIX, D_MODEL), D_MIX ** -0.5),
        'ffn_norm': gain(ks[24], (L, D_MODEL)),
        'w_router': nrm(ks[25], (L, D_MODEL, N_EXPERTS), D_MODEL ** -0.5),
        'b_router': nrm(ks[26], (L, N_EXPERTS), 0.01),
        'w_gate_up': nrm(ks[27], (L, N_EXPERTS, D_MODEL, 2 * D_EXPERT), D_MODEL ** -0.5),
        'b_gate_up': nrm(ks[28], (L, N_EXPERTS, 2 * D_EXPERT), 0.01),
        'w_down': nrm(ks[29], (L, N_EXPERTS, D_EXPERT, D_MODEL), D_EXPERT ** -0.5),
        'b_down': nrm(ks[30], (L, N_EXPERTS, D_MODEL), 0.01),
    }


def reference(x, mem, positions, attn_norm, w_in, q_a_norm, w_q_b, kv_a_norm, w_kv_b,
              q_nope_norm, q_rope_norm, k_nope_norm, k_rope_norm,
              gmlp_v_norm, w_spatial, b_spatial,
              mem_norm, w_mem_kv, mem_q_norm, mem_k_norm,
              mla_out_norm, gmlp_out_norm, mem_out_norm, w_o,
              ffn_norm, w_router, b_router, w_gate_up, b_gate_up, w_down, b_down):
    for l in range(DEPTH):
        h = rms_norm(x, attn_norm[l])
        x = x + token_mixers(h, mem, positions, w_in[l], q_a_norm[l], w_q_b[l], kv_a_norm[l], w_kv_b[l],
                             q_nope_norm[l], q_rope_norm[l], k_nope_norm[l], k_rope_norm[l],
                             gmlp_v_norm[l], w_spatial[l], b_spatial[l],
                             mem_norm[l], w_mem_kv[l], mem_q_norm[l], mem_k_norm[l],
                             mla_out_norm[l], gmlp_out_norm[l], mem_out_norm[l], w_o[l])
        h = rms_norm(x, ffn_norm[l])
        x = x + moe_ffn(h, w_router[l], b_router[l], w_gate_up[l], b_gate_up[l], w_down[l], b_down[l])
    return x
```

```cpp
#include <hip/hip_runtime.h>
#include <cstdio>
#include <cstdint>
#include <cmath>

#ifndef MK_N_LAUNCHES
#define MK_N_LAUNCHES 1
#endif
#ifndef DBG_LAST_PHASE
#define DBG_LAST_PHASE 9
#endif
#ifndef DUP_PHASE
#define DUP_PHASE -1
#endif
#define REPS(k) for (int rep_ = 0; rep_ < ((DUP_PHASE == (k)) ? 2 : 1); ++rep_)

#define GAS __attribute__((address_space(1)))
#define LAS __attribute__((address_space(3)))
typedef unsigned short bf16;
typedef short bf16x8 __attribute__((ext_vector_type(8)));
typedef short s16x4 __attribute__((ext_vector_type(4)));
typedef float f32x2 __attribute__((ext_vector_type(2)));
typedef float f32x4 __attribute__((ext_vector_type(4)));
typedef float f32x16 __attribute__((ext_vector_type(16)));
typedef unsigned u32x2 __attribute__((ext_vector_type(2)));
typedef unsigned u32x4 __attribute__((ext_vector_type(4)));
typedef int i32x4 __attribute__((ext_vector_type(4)));
typedef int i32x8 __attribute__((ext_vector_type(8)));

constexpr int NB = 4, SEQ = 4096, DM = 2048, NTOK = NB * SEQ;
constexpr int NMEM = 256, NMROWS = NB * NMEM;
constexpr int N1 = 2816;
constexpr int NE = 32, LCAP = 16384;
constexpr int PMAX = 73728;
constexpr float EPS = 1e-6f;
constexpr int NPHASE = 9;

constexpr size_t al256(size_t x) { return (x + 255) & ~(size_t)255; }
constexpr size_t WS_CTL = 0, CTL_BYTES = 1u << 20;
constexpr size_t WS_W1T = CTL_BYTES;
constexpr size_t WS_WMKVT = WS_W1T + al256((size_t)N1 * 2048 * 2);
constexpr size_t WS_WQBT = WS_WMKVT + al256((size_t)1024 * 2048 * 2);
constexpr size_t WS_WKVBT = WS_WQBT + al256((size_t)1536 * 512 * 2);
constexpr size_t WS_WOT = WS_WKVBT + al256((size_t)2048 * 512 * 2);
constexpr size_t WS_WSP = WS_WOT + al256((size_t)2048 * 2048 * 2);
constexpr size_t WS_WR4 = WS_WSP + al256((size_t)4 * 128 * 128 * 2);
constexpr size_t WS_WGUT = WS_WR4 + al256((size_t)2048 * 32 * 4);
constexpr size_t WS_WDT = WS_WGUT + al256((size_t)NE * 4096 * 2048);
constexpr size_t WS_XB = WS_WDT + al256((size_t)NE * 2048 * 2048);
constexpr size_t WS_MEMB = WS_XB + al256((size_t)NTOK * 2048 * 2);
constexpr size_t WS_RSTDX = WS_MEMB + al256((size_t)NMROWS * 2048 * 2);
constexpr size_t WS_RSTDM = WS_RSTDX + al256((size_t)NTOK * 4);
constexpr size_t WS_ROPEC = WS_RSTDM + al256((size_t)NMROWS * 4);
constexpr size_t WS_ROPES = WS_ROPEC + al256((size_t)NTOK * 32 * 4);
constexpr size_t WS_CQ = WS_ROPES + al256((size_t)NTOK * 32 * 4);
constexpr size_t WS_CKV = WS_CQ + al256((size_t)NTOK * 512 * 2);
constexpr size_t WS_U = WS_CKV + al256((size_t)NTOK * 512 * 2);
constexpr size_t WS_VG = WS_U + al256((size_t)NTOK * 512 * 2);
constexpr size_t WS_QM = WS_VG + al256((size_t)NTOK * 512 * 2);
constexpr size_t WS_KPE = WS_QM + al256((size_t)NTOK * 512 * 2);
constexpr size_t WS_MK = WS_KPE + al256((size_t)NTOK * 64 * 2);
constexpr size_t WS_MV = WS_MK + al256((size_t)NMROWS * 512 * 2);
constexpr size_t WS_PARTQ = WS_MV + al256((size_t)NMROWS * 512 * 2);
constexpr size_t WS_PARTKV = WS_PARTQ + al256((size_t)8 * NTOK * 4);
constexpr size_t WS_PARTVG = WS_PARTKV + al256((size_t)8 * NTOK * 4);
constexpr size_t WS_PARTA = WS_PARTVG + al256((size_t)8 * NTOK * 4);
constexpr size_t WS_PARTB = WS_PARTA + al256((size_t)8 * NTOK * 4);
constexpr size_t WS_PARTM = WS_PARTB + al256((size_t)16 * NTOK * 4);
constexpr size_t WS_PARTF = WS_PARTM + al256((size_t)4 * NTOK * 4);
constexpr size_t WS_QBUF = WS_PARTF + al256((size_t)32 * NTOK * 4);
constexpr size_t WS_KBUF = WS_QBUF + al256((size_t)NTOK * 1536 * 2);
constexpr size_t WS_VBUF = WS_KBUF + al256((size_t)NTOK * 1024 * 2);
constexpr size_t WS_OC = WS_VBUF + al256((size_t)NTOK * 1024 * 2);
constexpr size_t WS_XB1 = WS_OC + al256((size_t)NTOK * 2048 * 2);
constexpr size_t WS_LTOK = WS_XB1 + al256((size_t)NTOK * 2048);
constexpr size_t WS_LRS = WS_LTOK + al256((size_t)NE * LCAP * 4);
constexpr size_t WS_LGATE = WS_LRS + al256((size_t)NE * LCAP * 4);
constexpr size_t WS_SEL = WS_LGATE + al256((size_t)NE * LCAP * 4);
constexpr size_t WS_ACT = WS_SEL + al256((size_t)NTOK * 4 * 4);
constexpr size_t WS_Y = WS_ACT + al256((size_t)PMAX * 2048);
constexpr size_t WS_END = WS_Y + al256((size_t)PMAX * 2048);
constexpr int CW_BAR = 4096;
constexpr int CW_P3DONE = 32768;
constexpr int CW_CNT = 16384;

constexpr int RING_BYTES = 131072;
constexpr int EPI_OFF = 131072;
constexpr int S4_OFF = 139264;
constexpr int BIAS_OFF = 139264;
constexpr int ROW_OFF = 155648;
constexpr int MOE_OFF = 157696;
constexpr int MISC_OFF = 158720;
constexpr int PT_OFF = 158976;
constexpr int LDS_BYTES = 163840;
static_assert(S4_OFF + 8192 <= ROW_OFF && BIAS_OFF + 16384 <= ROW_OFF && ROW_OFF + 2048 <= MOE_OFF && MOE_OFF + 1024 <= MISC_OFF && PT_OFF + 256 <= LDS_BYTES && 8 * 16640 <= BIAS_OFF + 16384, "LDS map");

__device__ __forceinline__ unsigned cvt_pk_bf16(float lo, float hi) { unsigned r; asm volatile("v_cvt_pk_bf16_f32 %0, %1, %2" : "=v"(r) : "v"(lo), "v"(hi)); return r; }
__device__ __forceinline__ u32x4 pack8(f32x4 a, f32x4 b) { u32x4 w; w.x = cvt_pk_bf16(a[0], a[1]); w.y = cvt_pk_bf16(a[2], a[3]); w.z = cvt_pk_bf16(b[0], b[1]); w.w = cvt_pk_bf16(b[2], b[3]); return w; }
__device__ __forceinline__ void store8(bf16* p, f32x4 a, f32x4 b) { *(u32x4*)p = pack8(a, b); }
__device__ __forceinline__ u32x2 pack8_fp8(f32x4 a, f32x4 b) { int lo = __builtin_amdgcn_cvt_pk_fp8_f32(a[0], a[1], 0, false); lo = __builtin_amdgcn_cvt_pk_fp8_f32(a[2], a[3], lo, true);
    int hi = __builtin_amdgcn_cvt_pk_fp8_f32(b[0], b[1], 0, false); hi = __builtin_amdgcn_cvt_pk_fp8_f32(b[2], b[3], hi, true); return (u32x2){(unsigned)lo, (unsigned)hi}; }
__device__ __forceinline__ float dot4(f32x4 a) { return (a[0] * a[0] + a[1] * a[1]) + (a[2] * a[2] + a[3] * a[3]); }
__device__ __forceinline__ float red4(float s) { s += __shfl_xor(s, 16); s += __shfl_xor(s, 32); return s; }
__device__ __forceinline__ float wave_sum(float v) {
#pragma unroll
    for (int o = 1; o < 64; o <<= 1) v += __shfl_xor(v, o);
    return v;
}
__device__ __forceinline__ int fresh_lane() { int l; asm volatile("v_mbcnt_lo_u32_b32 %0, -1, 0\n\tv_mbcnt_hi_u32_b32 %0, -1, %0" : "=v"(l)); return l; }
__device__ __forceinline__ float bf2f(unsigned short b) { return __uint_as_float(((unsigned)b) << 16); }
__device__ __forceinline__ f32x2 gelu_pk(f32x2 v) {
    const f32x2 av = __builtin_elementwise_abs(v), d = av * 0.2316418882f + 1.0f;
    f32x2 t; t.x = __builtin_amdgcn_rcpf(d.x); t.y = __builtin_amdgcn_rcpf(d.y);
    f32x2 q = t * 0.5307027145f + (-0.7265760135f); q = q * t + 0.7107068705f; q = q * t + (-0.142248368f); q = q * t + 0.127414796f; q = q * t;
    const f32x2 s = (v * v) * (-0.72134752044f);
    f32x2 e; e.x = __builtin_amdgcn_exp2f(s.x); e.y = __builtin_amdgcn_exp2f(s.y);
    const f32x2 m = v * (q * e), r = v - m;
    f32x2 o; o.x = v.x < 0.f ? m.x : r.x; o.y = v.y < 0.f ? m.y : r.y; return o;
}
__device__ __forceinline__ f32x4 gelu4(f32x4 v) { f32x2 a = gelu_pk((f32x2){v[0], v[1]}), b = gelu_pk((f32x2){v[2], v[3]}); return (f32x4){a.x, a.y, b.x, b.y}; }

struct Args {
    const float* in[31];
    float* out;
    unsigned char* ws;
    float invf[32];
    int ph_lo, ph_hi;
};

namespace pg8 {
constexpr int BM = 256, BK = 64, HALF = 128, HTB = HALF * BK * 2, STAGE_BYTES = 8 * HTB;
__host__ __device__ __forceinline__ int lds_byte(int r, int cb) { return (r >> 3) * 1024 + (r & 7) * 128 + ((((cb >> 4) ^ ((r >> 1) & 7)) << 4) | (cb & 15)); }
__host__ __device__ __forceinline__ void stage_rc(int b, int& R, int& CB) { const int r = (b >> 10) * 8 + ((b >> 7) & 7); R = r; CB = ((((b >> 4) & 7) ^ ((r >> 1) & 7)) << 4) | (b & 15); }
__host__ __device__ __forceinline__ int perm32(int rho) { const int n = rho >> 4, i = rho & 15; return 8 * (i >> 2) + 4 * n + (i & 3); }

template <class Epi, class Sched, bool GATHER, bool FP8>
__device__ __forceinline__ void gemm_phase(LAS unsigned char* lds, const int nt, const int pitchA, const int kstA, const int pitchB, const int kstB, const Sched& S, const Epi& E) {
    typedef typename Sched::Unit Unit;
    const int tid = threadIdx.x, wid = __builtin_amdgcn_readfirstlane(tid >> 6), lane = tid & 63, wr = wid >> 2, wc = wid & 3, fr = lane & 15, fq = lane >> 4;
    unsigned voffA[2], voffB[2]; int RA[2], CA[2];
#pragma unroll
    for (int i = 0; i < 2; ++i) { int R, C; stage_rc(tid * 16 + i * 8192, R, C); const int Rb = (R & ~31) + perm32(R & 31); RA[i] = R; CA[i] = C;
        voffA[i] = (unsigned)(R * pitchA + C); voffB[i] = (unsigned)(Rb * pitchB + C); }
    const size_t kstepA = (size_t)kstA, kstepB = (size_t)kstB;
    const unsigned hstep = (unsigned)HALF * (unsigned)pitchA, hstepB = (unsigned)HALF * (unsigned)pitchB;
    const unsigned ldsw = (unsigned)wid * 1024u;
    const int aoff0 = lds_byte(wr * 64 + fr, fq * 16), aoff1 = lds_byte(wr * 64 + fr, 64 + fq * 16), boff0 = lds_byte(wc * 32 + fr, fq * 16), boff1 = lds_byte(wc * 32 + fr, 64 + fq * 16);
#define PG8_SA(b, h) (((b) * 2 + (h)) * HTB)
#define PG8_SB(b, h) ((4 + (b) * 2 + (h)) * HTB)
#define PG8_STAGE_B(bufoff, gbase) do { _Pragma("unroll") for (int _i = 0; _i < 2; ++_i) { unsigned _o = voffB[_i]; asm volatile("" : "+v"(_o));     \
        __builtin_amdgcn_global_load_lds((const unsigned*)((const char*)(gbase) + _o), (LAS unsigned*)(lds + (bufoff) + ldsw + _i * 8192), 16, 0, 0); } } while (0)
#define PG8_STAGE_A(bufoff, kptr, h) do { _Pragma("unroll") for (int _i = 0; _i < 2; ++_i) { \
        unsigned _o = GATHER ? vC[h][_i] : (voffA[_i] + (unsigned)(h) * hstep); asm volatile("" : "+v"(_o)); \
        __builtin_amdgcn_global_load_lds((const unsigned*)((const char*)(kptr) + _o), (LAS unsigned*)(lds + (bufoff) + ldsw + _i * 8192), 16, 0, 0); } } while (0)
#define PG8_LDA(dst, b, h) do { _Pragma("unroll") for (int m = 0; m < 4; ++m) _Pragma("unroll") for (int k = 0; k < 2; ++k) dst[m][k] = *(const LAS i32x4*)(lds + PG8_SA(b, h) + (k ? aoff1 : aoff0) + m * 2048); } while (0)
#define PG8_LDB(dst, b, h) do { _Pragma("unroll") for (int n = 0; n < 2; ++n) _Pragma("unroll") for (int k = 0; k < 2; ++k) dst[n][k] = *(const LAS i32x4*)(lds + PG8_SB(b, h) + (k ? boff1 : boff0) + n * 2048); } while (0)
#define PG8_MMA(ai, bj, At, Bt) do { __builtin_amdgcn_s_setprio(1); _Pragma("unroll") for (int m = 0; m < 4; ++m) _Pragma("unroll") for (int n = 0; n < 2; ++n) { \
        if constexpr (FP8) { acc[ai][bj][m][n] = __builtin_amdgcn_mfma_scale_f32_16x16x128_f8f6f4(__builtin_shufflevector(Bt[n][0], Bt[n][1], 0, 1, 2, 3, 4, 5, 6, 7), __builtin_shufflevector(At[m][0], At[m][1], 0, 1, 2, 3, 4, 5, 6, 7), \
                acc[ai][bj][m][n], 0, 0, 0, 0, 0, 0); } \
        else { _Pragma("unroll") for (int k = 0; k < 2; ++k) acc[ai][bj][m][n] = __builtin_amdgcn_mfma_f32_16x16x32_bf16(__builtin_bit_cast(bf16x8, Bt[n][k]), __builtin_bit_cast(bf16x8, At[m][k]), acc[ai][bj][m][n], 0, 0, 0); } } \
        __builtin_amdgcn_s_setprio(0); } while (0)
#define PG8_WAIT_V(n) asm volatile("s_waitcnt vmcnt(" #n ")" ::: "memory")
#define PG8_WAIT_L(n) asm volatile("s_waitcnt lgkmcnt(" #n ")" ::: "memory")
#define PG8_BAR __builtin_amdgcn_s_barrier()
#define PG8_SCHED __builtin_amdgcn_sched_barrier(0)
    Unit cur, nxt; int ui = 0;
    if (!S.next(0, cur)) return;
    f32x4 acc[2][2][4][2];
#pragma unroll
    for (int a = 0; a < 2; ++a)
#pragma unroll
        for (int b = 0; b < 2; ++b)
#pragma unroll
            for (int m = 0; m < 4; ++m)
#pragma unroll
                for (int n = 0; n < 2; ++n) acc[a][b][m][n] = (f32x4){0.f, 0.f, 0.f, 0.f};
    i32x4 At[4][2], B0[2][2], B1[2][2];
    const char* cA = cur.A; const char* cB = cur.B;
    unsigned vC[2][2];
    LAS u32x4* stash = (LAS u32x4*)(lds + EPI_OFF) + tid;
    if constexpr (GATHER) {
#pragma unroll
        for (int h = 0; h < 2; ++h)
#pragma unroll
            for (int i = 0; i < 2; ++i) vC[h][i] = S.row_off(cur, h * 128 + RA[i]) + (unsigned)CA[i];
    } else {
#pragma unroll
        for (int h = 0; h < 2; ++h)
#pragma unroll
            for (int i = 0; i < 2; ++i) vC[h][i] = 0u;
    }
    if constexpr (Epi::BEGIN) E.begin(cur, 0, lds);
    int mseq = 0;
    if constexpr (Epi::META) { E.meta_load(cur, 0, lds); E.bias_load(cur, lds); }
    PG8_STAGE_B(PG8_SB(0, 0), cB); PG8_STAGE_B(PG8_SB(0, 1), cB + hstepB); PG8_STAGE_A(PG8_SA(0, 0), cA, 0); PG8_STAGE_A(PG8_SA(0, 1), cA, 1);
    if (wr == 1) PG8_BAR;
    PG8_WAIT_V(2); PG8_BAR;
    PG8_STAGE_B(PG8_SB(1, 0), cB + kstepB); PG8_STAGE_A(PG8_SA(1, 0), cA + kstepA, 0); PG8_STAGE_B(PG8_SB(1, 1), cB + hstepB + kstepB);
    PG8_WAIT_V(6); PG8_BAR;
    for (;;) {
        const bool has_next = S.next(ui + 1, nxt);
        const char* nA = has_next ? nxt.A : cA; const char* nB = has_next ? nxt.B : cB;
        bool nnew = true;
        if constexpr (Epi::META) { nnew = has_next && nxt.newm; if (nnew) E.meta_load(nxt, (mseq + 1) & 1, lds); }
        if constexpr (GATHER) {
            if (has_next && nnew) { const int t2 = wid * 64 + fresh_lane(); u32x4 vn;
#pragma unroll
                for (int i = 0; i < 2; ++i) { int R, C; stage_rc(t2 * 16 + i * 8192, R, C);
#pragma unroll
                    for (int h = 0; h < 2; ++h) vn[h * 2 + i] = S.row_off(nxt, h * 128 + R) + (unsigned)C; }
                *stash = vn; }
        }
        for (int t = 0; t < nt; t += 2) {
            const bool last = (t == nt - 2);
            if constexpr (Epi::KHOOK) E.khook(acc, t, wr, fr, ui, lds);
            const char* a1 = cA + (size_t)(t + 1) * kstepA;
            const char* a2 = last ? nA : cA + (size_t)(t + 2) * kstepA; const char* b2 = last ? nB : cB + (size_t)(t + 2) * kstepB;
            const char* a3 = a2 + kstepA; const char* b3 = b2 + kstepB;
            PG8_LDB(B0, 0, 0); PG8_LDB(B1, 0, 1); PG8_SCHED; PG8_LDA(At, 0, 0); PG8_STAGE_A(PG8_SA(1, 1), a1, 1);
            if constexpr (GATHER) { if (last && has_next && nnew) { const u32x4 vn = *stash; vC[0][0] = vn[0]; vC[0][1] = vn[1]; vC[1][0] = vn[2]; vC[1][1] = vn[3]; } }
            PG8_WAIT_V(8); PG8_WAIT_L(0); PG8_BAR; PG8_MMA(0, 0, At, B0); PG8_MMA(0, 1, At, B1); PG8_BAR; PG8_SCHED;
            PG8_LDA(At, 0, 1); PG8_STAGE_B(PG8_SB(0, 0), b2); PG8_STAGE_B(PG8_SB(0, 1), b2 + hstepB); PG8_STAGE_A(PG8_SA(0, 0), a2, 0);
            PG8_WAIT_V(8); PG8_WAIT_L(0); PG8_BAR; PG8_MMA(1, 0, At, B0); PG8_MMA(1, 1, At, B1); PG8_BAR; PG8_SCHED;
            PG8_LDB(B0, 1, 0); PG8_LDB(B1, 1, 1); PG8_SCHED; PG8_LDA(At, 1, 0); PG8_STAGE_A(PG8_SA(0, 1), a2, 1);
            PG8_WAIT_V(8); PG8_WAIT_L(0); PG8_BAR; PG8_MMA(0, 0, At, B0); PG8_MMA(0, 1, At, B1); PG8_BAR; PG8_SCHED;
            PG8_LDA(At, 1, 1); PG8_STAGE_B(PG8_SB(1, 0), b3); PG8_STAGE_B(PG8_SB(1, 1), b3 + hstepB); PG8_STAGE_A(PG8_SA(1, 0), a3, 0);
            PG8_WAIT_V(8); PG8_WAIT_L(0); PG8_BAR; PG8_MMA(1, 0, At, B0); PG8_MMA(1, 1, At, B1); PG8_BAR; PG8_SCHED;
        }
        if (wr == 0) PG8_BAR;
        { const int l2 = fresh_lane(); E(acc, cur, wr, wc, l2 & 15, l2 >> 4, Epi::META ? mseq : ui, lds); }
        if (!has_next) break;
#pragma unroll
        for (int a = 0; a < 2; ++a)
#pragma unroll
            for (int b = 0; b < 2; ++b)
#pragma unroll
                for (int m = 0; m < 4; ++m)
#pragma unroll
                    for (int n = 0; n < 2; ++n) acc[a][b][m][n] = (f32x4){0.f, 0.f, 0.f, 0.f};
        if constexpr (Epi::META) { if (nnew) { ++mseq; if (nxt.e != cur.e) { PG8_BAR; E.bias_load(nxt, lds); } } }
        cur = nxt; cA = nA; cB = nB; ++ui;
        if constexpr (Epi::BEGIN) E.begin(cur, ui, lds);
        if (wr == 1) PG8_BAR;
    }
    PG8_WAIT_V(0);
    PG8_BAR;
#undef PG8_SA
#undef PG8_SB
#undef PG8_STAGE_A
#undef PG8_STAGE_B
#undef PG8_LDA
#undef PG8_LDB
#undef PG8_MMA
#undef PG8_WAIT_V
#undef PG8_WAIT_L
#undef PG8_BAR
#undef PG8_SCHED
}
}

typedef f32x4 AccT[2][2][4][2];
#define ROWL(ai, m) (128 * (ai) + 64 * wr + 16 * (m) + fr)
#define COLL(bj) (128 * (bj) + 32 * wc + 8 * fq)

__device__ __forceinline__ void normalize_halves(AccT& acc, LAS unsigned char* lds, int wr, int wc, int fr, int fq, bool apply) {
    LAS float* P = (LAS float*)(lds + EPI_OFF);
    float r[2][4][2];
    if (apply) {
#pragma unroll
        for (int ai = 0; ai < 2; ++ai)
#pragma unroll
            for (int m = 0; m < 4; ++m)
#pragma unroll
                for (int bj = 0; bj < 2; ++bj) { float s = dot4(acc[ai][bj][m][0]) + dot4(acc[ai][bj][m][1]); s = red4(s);
                    if (fq == 0) P[(bj * 256 + ROWL(ai, m)) * 4 + wc] = s; }
        asm volatile("s_waitcnt lgkmcnt(0)" ::: "memory"); __builtin_amdgcn_s_barrier(); asm volatile("" ::: "memory");
#pragma unroll
        for (int ai = 0; ai < 2; ++ai)
#pragma unroll
            for (int m = 0; m < 4; ++m)
#pragma unroll
                for (int bj = 0; bj < 2; ++bj) { const f32x4 p = *(const LAS f32x4*)(P + (bj * 256 + ROWL(ai, m)) * 4);
                    r[ai][m][bj] = rsqrtf(((p[0] + p[1]) + (p[2] + p[3])) * (1.0f / 128.0f) + EPS); }
        asm volatile("s_waitcnt lgkmcnt(0)" ::: "memory");
    } else {
#pragma unroll
        for (int ai = 0; ai < 2; ++ai)
#pragma unroll
            for (int m = 0; m < 4; ++m) { r[ai][m][0] = 1.0f; r[ai][m][1] = 1.0f; }
    }
#pragma unroll
    for (int ai = 0; ai < 2; ++ai)
#pragma unroll
        for (int m = 0; m < 4; ++m)
#pragma unroll
            for (int bj = 0; bj < 2; ++bj) { float f = r[ai][m][bj]; asm volatile("" : "+v"(f)); acc[ai][bj][m][0] *= f; acc[ai][bj][m][1] *= f; }
}
__device__ __forceinline__ void rope_rows(AccT& acc, int row0, int wr, int fr, int fq, const float* RC, const float* RS, bf16* dst, int pitch, int coloff) {
#pragma unroll
    for (int ai = 0; ai < 2; ++ai)
#pragma unroll
        for (int m = 0; m < 4; ++m) {
            const int row = row0 + ROWL(ai, m);
            float s = dot4(acc[ai][0][m][0]) + dot4(acc[ai][0][m][1]) + dot4(acc[ai][1][m][0]) + dot4(acc[ai][1][m][1]); s = red4(s);
            const float r = rsqrtf(s * (1.0f / 64.0f) + EPS);
            const f32x4 c0 = *(const f32x4*)(RC + (size_t)row * 32 + 8 * fq), c1 = *(const f32x4*)(RC + (size_t)row * 32 + 8 * fq + 4);
            const f32x4 s0 = *(const f32x4*)(RS + (size_t)row * 32 + 8 * fq), s1 = *(const f32x4*)(RS + (size_t)row * 32 + 8 * fq + 4);
            const f32x4 a0 = acc[ai][0][m][0] * r, a1 = acc[ai][0][m][1] * r, b0 = acc[ai][1][m][0] * r, b1 = acc[ai][1][m][1] * r;
            bf16* d = dst + (size_t)row * pitch + coloff + 8 * fq;
            store8(d, a0 * c0 - b0 * s0, a1 * c1 - b1 * s1);
            store8(d + 32, a0 * s0 + b0 * c0, a1 * s1 + b1 * c1);
            asm volatile("" ::: "memory");
        }
}

struct UnitG { const char* A; const char* B; int pm, pn, kind; };
struct Sched1 {
    typedef UnitG Unit;
    int G, c; const bf16 *XB, *W1T, *MEMB, *WMKVT;
    __device__ __forceinline__ bool next(int i, Unit& u) const {
        const int L = i * G + c; if (L >= 720) return false;
        if (L < 704) { const int g8 = L / 88, r = L - g8 * 88; u.pm = g8 * 8 + (r & 7); u.pn = r >> 3; u.kind = 0;
            u.A = (const char*)(XB + (size_t)u.pm * 256 * 2048); u.B = (const char*)(W1T + (size_t)u.pn * 256 * 2048); }
        else { const int r = L - 704; u.pm = r >> 2; u.pn = r & 3; u.kind = 1;
            u.A = (const char*)(MEMB + (size_t)u.pm * 256 * 2048); u.B = (const char*)(WMKVT + (size_t)u.pn * 256 * 2048); }
        return true;
    }
};
struct Epi1 {
    static constexpr bool KHOOK = false, BEGIN = false, META = false;
    const float *rstdx, *rstdm, *RC, *RS; bf16 *CQ, *CKV, *U, *VG, *QM, *KPE, *MK, *MV; float *PARTQ, *PARTKV, *PARTVG;
    __device__ __forceinline__ void operator()(AccT& acc, const UnitG& u, int wr, int wc, int fr, int fq, int, LAS unsigned char* lds) const {
        const int row0 = u.pm * 256, pn = u.pn; const float* rsp = (u.kind ? rstdm : rstdx) + row0;
#pragma unroll
        for (int ai = 0; ai < 2; ++ai)
#pragma unroll
            for (int m = 0; m < 4; ++m) { const float rs = rsp[ROWL(ai, m)];
#pragma unroll
                for (int bj = 0; bj < 2; ++bj) { acc[ai][bj][m][0] *= rs; acc[ai][bj][m][1] *= rs; } }
        asm volatile("" ::: "memory");
        normalize_halves(acc, lds, wr, wc, fr, fq, (u.kind == 1 && pn < 2) || (u.kind == 0 && pn >= 8 && pn < 10));
        if (u.kind == 1 || (pn >= 8 && pn < 10)) {
            bf16* dst = u.kind == 1 ? (pn < 2 ? MK + pn * 256 : MV + (pn - 2) * 256) : QM + (pn - 8) * 256;
            dst += 32 * wc + 8 * fq;
#pragma unroll
            for (int ai = 0; ai < 2; ++ai)
#pragma unroll
                for (int m = 0; m < 4; ++m) {
#pragma unroll
                    for (int bj = 0; bj < 2; ++bj) store8(dst + (size_t)(row0 + ROWL(ai, m)) * 512 + 128 * bj, acc[ai][bj][m][0], acc[ai][bj][m][1]);
                    asm volatile("" ::: "memory"); }
            return;
        }
        if (pn < 4) {
            bf16* dst = (pn < 2 ? CQ : CKV) + (pn & 1) * 256 + 32 * wc + 8 * fq; float* part = (pn < 2 ? PARTQ : PARTKV) + (size_t)((pn & 1) * 4 + wc) * NTOK;
#pragma unroll
            for (int ai = 0; ai < 2; ++ai)
#pragma unroll
                for (int m = 0; m < 4; ++m) { const int row = row0 + ROWL(ai, m); float ss = 0.f;
#pragma unroll
                    for (int bj = 0; bj < 2; ++bj) { ss += dot4(acc[ai][bj][m][0]) + dot4(acc[ai][bj][m][1]); store8(dst + (size_t)row * 512 + 128 * bj, acc[ai][bj][m][0], acc[ai][bj][m][1]); }
                    ss = red4(ss); if (fq == 0) part[row] = ss;
                    asm volatile("" ::: "memory"); }
        } else if (pn < 8) {
            bf16* dst = (pn < 6 ? U : VG) + (pn & 1) * 256 + 32 * wc + 8 * fq; float* part = PARTVG + (size_t)((pn & 1) * 4 + wc) * NTOK;
#pragma unroll
            for (int ai = 0; ai < 2; ++ai)
#pragma unroll
                for (int m = 0; m < 4; ++m) { const int row = row0 + ROWL(ai, m); float ss = 0.f;
#pragma unroll
                    for (int bj = 0; bj < 2; ++bj) { const f32x4 g0 = gelu4(acc[ai][bj][m][0]), g1 = gelu4(acc[ai][bj][m][1]); ss += dot4(g0) + dot4(g1); store8(dst + (size_t)row * 512 + 128 * bj, g0, g1); }
                    ss = red4(ss); if (pn >= 6 && fq == 0) part[row] = ss;
                    asm volatile("" ::: "memory"); }
        } else {
            if (wc == 0) rope_rows(acc, row0, wr, fr, fq, RC, RS, KPE, 64, 0);
        }
    }
};

struct Sched2 {
    typedef UnitG Unit;
    int G, c; const bf16 *CQ, *CKV, *WQBT, *WKVBT;
    __device__ __forceinline__ bool next(int i, Unit& u) const {
        const int L = i * G + c; if (L >= 896) return false;
        const int g8 = L / 112, r = L - g8 * 112; u.pm = g8 * 8 + (r & 7); const int pn = r >> 3;
        if (pn < 6) { u.kind = 0; u.pn = pn; u.A = (const char*)(CQ + (size_t)u.pm * 256 * 512); u.B = (const char*)(WQBT + (size_t)pn * 256 * 512); }
        else { u.kind = 1; u.pn = pn - 6; u.A = (const char*)(CKV + (size_t)u.pm * 256 * 512); u.B = (const char*)(WKVBT + (size_t)(pn - 6) * 256 * 512); }
        return true;
    }
};
struct Epi2 {
    static constexpr bool KHOOK = false, BEGIN = true, META = false;
    const float *PARTQ, *PARTKV, *RC, *RS; bf16 *QBUF, *KBUF, *VBUF;
    __device__ __forceinline__ void begin(const UnitG& u, int ui, LAS unsigned char* lds) const {
        if (threadIdx.x < 256) {
            LAS float* S4 = (LAS float*)(lds + S4_OFF) + (ui & 1) * 1024;
            const float* part = (u.kind ? PARTKV : PARTQ) + u.pm * 256 + threadIdx.x; float s = 0.f;
#pragma unroll
            for (int k = 0; k < 8; ++k) s += part[(size_t)k * NTOK];
            S4[threadIdx.x * 4] = rsqrtf(s * (1.0f / 512.0f) + EPS);
        }
    }
    __device__ __forceinline__ void operator()(AccT& acc, const UnitG& u, int wr, int wc, int fr, int fq, int ui, LAS unsigned char* lds) const {
        const LAS float* S4 = (const LAS float*)(lds + S4_OFF) + (ui & 1) * 1024;
        const int row0 = u.pm * 256, pn = u.pn;
#pragma unroll
        for (int ai = 0; ai < 2; ++ai)
#pragma unroll
            for (int m = 0; m < 4; ++m) { const float rs = S4[ROWL(ai, m) * 4];
#pragma unroll
                for (int bj = 0; bj < 2; ++bj) { acc[ai][bj][m][0] *= rs; acc[ai][bj][m][1] *= rs; } }
        normalize_halves(acc, lds, wr, wc, fr, fq, pn < 4);
        if (u.kind == 0 && pn >= 4) {
            const int h = 4 * (pn - 4) + wc;
            rope_rows(acc, row0, wr, fr, fq, RC, RS, QBUF, 1536, h * 192 + 128);
            return;
        }
        bf16* dst; int pitch, hs;
        if (u.kind == 0) { dst = QBUF + (2 * pn) * 192; pitch = 1536; hs = 192; }
        else if (pn < 4) { dst = KBUF + (2 * pn) * 128; pitch = 1024; hs = 128; }
        else { dst = VBUF + (2 * (pn - 4)) * 128; pitch = 1024; hs = 128; }
        dst += 32 * wc + 8 * fq;
#pragma unroll
        for (int ai = 0; ai < 2; ++ai)
#pragma unroll
            for (int m = 0; m < 4; ++m) {
#pragma unroll
                for (int bj = 0; bj < 2; ++bj) store8(dst + (size_t)(row0 + ROWL(ai, m)) * pitch + bj * hs, acc[ai][bj][m][0], acc[ai][bj][m][1]);
                asm volatile("" ::: "memory"); }
    }
};

struct Sched4 {
    typedef UnitG Unit;
    int G, c, cnt; const bf16 *OC, *WOT;
    __device__ __forceinline__ bool next(int i, Unit& u) const {
        const int L = i * G + c; if (i >= cnt || L >= 512) return false;
        const int g8 = L >> 6, r = L & 63; u.pm = g8 * 8 + (r & 7); u.pn = r >> 3; u.kind = 0;
        u.A = (const char*)(OC + (size_t)u.pm * 256 * 2048); u.B = (const char*)(WOT + (size_t)u.pn * 256 * 2048); return true;
    }
};
struct Epi4 {
    static constexpr bool KHOOK = true, BEGIN = true, META = false;
    const float *PARTA, *PARTB, *PARTM, *fgain; bf16* xb; float* PARTF; unsigned char* XQ1;
    __device__ __forceinline__ void begin(const UnitG& u, int ui, LAS unsigned char* lds) const {
        if (threadIdx.x < 256) {
            LAS float* S4 = (LAS float*)(lds + S4_OFF) + (ui & 1) * 1024;
            const int row = u.pm * 256 + threadIdx.x; float sa = 0.f, sb = 0.f, sc = 0.f;
#pragma unroll
            for (int k = 0; k < 8; ++k) sa += PARTA[(size_t)k * NTOK + row];
#pragma unroll
            for (int k = 0; k < 16; ++k) sb += PARTB[(size_t)k * NTOK + row];
#pragma unroll
            for (int k = 0; k < 4; ++k) sc += PARTM[(size_t)k * NTOK + row];
            const float rA = rsqrtf(sa * (1.0f / 1024.0f) + EPS), rB = rsqrtf(sb * (1.0f / 512.0f) + EPS), rC = rsqrtf(sc * (1.0f / 512.0f) + EPS);
            *(LAS f32x4*)(S4 + threadIdx.x * 4) = (f32x4){rA / rB, rB / rC, rC, 0.f};
        }
    }
    __device__ __forceinline__ void khook(AccT& acc, int t, int wr, int fr, int ui, LAS unsigned char* lds) const {
        if (t == 16 || t == 24) {
            const LAS float* S4 = (const LAS float*)(lds + S4_OFF) + (ui & 1) * 1024 + (t == 16 ? 0 : 1);
#pragma unroll
            for (int ai = 0; ai < 2; ++ai)
#pragma unroll
                for (int m = 0; m < 4; ++m) { const float f = S4[ROWL(ai, m) * 4];
#pragma unroll
                    for (int bj = 0; bj < 2; ++bj) { acc[ai][bj][m][0] *= f; acc[ai][bj][m][1] *= f; } }
        }
    }
    __device__ __forceinline__ void operator()(AccT& acc, const UnitG& u, int wr, int wc, int fr, int fq, int ui, LAS unsigned char* lds) const {
        const LAS float* S4 = (const LAS float*)(lds + S4_OFF) + (ui & 1) * 1024;
        const int row0 = u.pm * 256, col0 = u.pn * 256; float* part = PARTF + (size_t)(u.pn * 4 + wc) * NTOK;
        u32x4 xw[2][4][2];
#define EPI4_LD(ai, m) do { _Pragma("unroll") for (int bj = 0; bj < 2; ++bj) xw[ai][m][bj] = *(const u32x4*)(xb + (size_t)(row0 + ROWL(ai, m)) * 2048 + col0 + COLL(bj)); } while (0)
#define EPI4_ROW(ai, m) do { const int row = row0 + ROWL(ai, m); const float rC = S4[ROWL(ai, m) * 4 + 2]; float ss = 0.f; \
        _Pragma("unroll") for (int bj = 0; bj < 2; ++bj) { const size_t o = (size_t)row * 2048 + col0 + COLL(bj); const u32x4 w = xw[ai][m][bj]; \
            const f32x4 x0 = {__uint_as_float(w[0] << 16), __uint_as_float(w[0] & 0xffff0000u), __uint_as_float(w[1] << 16), __uint_as_float(w[1] & 0xffff0000u)}; \
            const f32x4 x1 = {__uint_as_float(w[2] << 16), __uint_as_float(w[2] & 0xffff0000u), __uint_as_float(w[3] << 16), __uint_as_float(w[3] & 0xffff0000u)}; \
            const f32x4 o0 = x0 + acc[ai][bj][m][0] * rC, o1 = x1 + acc[ai][bj][m][1] * rC; \
            *(u32x4*)(xb + o) = (u32x4){cvt_pk_bf16(o0[0], o0[1]), cvt_pk_bf16(o0[2], o0[3]), cvt_pk_bf16(o1[0], o1[1]), cvt_pk_bf16(o1[2], o1[3])}; \
            *(u32x2*)(XQ1 + o) = pack8_fp8(o0 * fg[bj][0], o1 * fg[bj][1]); ss += dot4(o0) + dot4(o1); } \
        ss = red4(ss); if (fq == 0) part[row] = ss; asm volatile("" ::: "memory"); } while (0)
        EPI4_LD(0, 0); EPI4_LD(0, 1); EPI4_LD(0, 2); EPI4_LD(0, 3); EPI4_LD(1, 0); EPI4_LD(1, 1);
        f32x4 fg[2][2];
#pragma unroll
        for (int bj = 0; bj < 2; ++bj) { fg[bj][0] = *(const f32x4*)(fgain + col0 + COLL(bj)); fg[bj][1] = *(const f32x4*)(fgain + col0 + COLL(bj) + 4); }
        asm volatile("" ::: "memory");
        EPI4_ROW(0, 0); EPI4_LD(1, 2); EPI4_ROW(0, 1); EPI4_LD(1, 3); EPI4_ROW(0, 2); EPI4_ROW(0, 3);
        EPI4_ROW(1, 0); EPI4_ROW(1, 1); EPI4_ROW(1, 2); EPI4_ROW(1, 3);
#undef EPI4_LD
#undef EPI4_ROW
    }
};

struct UnitM { const char* A; const char* B; int pn, e, mtl, cnt, pstart; bool newm; };
template <bool UP> struct SchedM {
    typedef UnitM Unit;
    int G, c; const LAS int* T;
    const unsigned char *Amat, *Wt; const int* LTOK;
    static constexpr int NPN = UP ? 16 : 8;
    __device__ __forceinline__ void where(int i, int& mt, int& pn) const {
        if (G == 256) { if (i < NPN) { mt = 32 * (c & 7) + (c >> 3); pn = i; } else { const int L = c + 256 * (i - NPN); mt = 256 + L / NPN; pn = L % NPN; } }
        else { const int L = i * G + c; mt = L / NPN; pn = L - mt * NPN; }
    }
    __device__ __forceinline__ bool next(int i, Unit& u) const {
        int mt, pnn; where(i, mt, pnn);
        if (mt >= __builtin_amdgcn_readfirstlane(T[32])) return false;
        int mtp = -1, pnp; if (i > 0) where(i - 1, mtp, pnp); (void)pnp;
        const int lane = fresh_lane();
        const unsigned long long bal = __ballot(lane < 32 && mt >= T[(lane & 31) + 1]);
        const int e = __builtin_popcountll(bal);
        u.pn = pnn; u.e = e; u.newm = (mt != mtp);
        u.mtl = mt - __builtin_amdgcn_readfirstlane(T[e]); u.cnt = __builtin_amdgcn_readfirstlane(T[128 + e]); u.pstart = __builtin_amdgcn_readfirstlane(T[64 + e]);
        u.A = (const char*)Amat;
        u.B = (const char*)(Wt + ((size_t)e * NPN + (size_t)u.pn) * 524288);
        return true;
    }
    __device__ __forceinline__ unsigned row_off(const Unit& u, int rl) const {
        const int slot = u.mtl * 256 + rl;
        if (UP) { const int tok = slot < u.cnt ? LTOK[u.e * LCAP + slot] : 0; return (unsigned)tok * 2048u; }
        else return (unsigned)(((u.pstart >> 8) + u.mtl) * 16 * 256 + rl) * 128u;
    }
};
struct Epi6 {
    static constexpr bool KHOOK = false, BEGIN = false, META = true;
    const float *LRS, *BGU; unsigned char* ACT;
    __device__ __forceinline__ void meta_load(const UnitM& u, int par, LAS unsigned char* lds) const {
        if (threadIdx.x < 256) { const int slot = u.mtl * 256 + threadIdx.x;
            ((LAS float*)(lds + ROW_OFF))[par * 256 + threadIdx.x] = slot < u.cnt ? LRS[u.e * LCAP + slot] * 0.03125f : 0.f; }
    }
    __device__ __forceinline__ void bias_load(const UnitM& u, LAS unsigned char* lds) const {
        const f32x4* src = (const f32x4*)(BGU + (size_t)u.e * 4096) + threadIdx.x; LAS f32x4* dst = (LAS f32x4*)(lds + BIAS_OFF) + threadIdx.x;
        dst[0] = src[0]; dst[512] = src[512];
    }
    __device__ __forceinline__ void operator()(AccT& acc, const UnitM& u, int wr, int wc, int fr, int fq, int mseq, LAS unsigned char* lds) const {
        const int colg = u.pn * 128 + 32 * wc + 8 * fq; const LAS float* bg = (const LAS float*)(lds + BIAS_OFF) + colg; const LAS float* rowf = (const LAS float*)(lds + ROW_OFF) + (mseq & 1) * 256;
        const f32x4 bg0 = *(const LAS f32x4*)bg, bg1 = *(const LAS f32x4*)(bg + 4), bu0 = *(const LAS f32x4*)(bg + 2048), bu1 = *(const LAS f32x4*)(bg + 2052);
#pragma unroll
        for (int ai = 0; ai < 2; ++ai)
#pragma unroll
            for (int m = 0; m < 4; ++m) { const int slot = u.mtl * 256 + ROWL(ai, m); const float rs = rowf[ROWL(ai, m)];
                f32x4 g[2] = {acc[ai][0][m][0] * rs + bg0, acc[ai][0][m][1] * rs + bg1}, up[2] = {acc[ai][1][m][0] * rs + bu0, acc[ai][1][m][1] * rs + bu1}, a[2];
#pragma unroll
                for (int n = 0; n < 2; ++n)
#pragma unroll
                    for (int j = 0; j < 4; ++j) { const float gg = fminf(g[n][j], 7.0f), uu = fminf(fmaxf(up[n][j], -7.0f), 7.0f);
                        const float sg = __builtin_amdgcn_rcpf(1.0f + __builtin_amdgcn_exp2f(gg * (-1.702f * 1.4426950408889634f)));
                        a[n][j] = (uu + 1.0f) * (gg * sg); }
                *(u32x2*)(ACT + ((size_t)(((u.pstart >> 8) + u.mtl) * 16 + u.pn) * 256 + ROWL(ai, m)) * 128 + 32 * wc + 8 * fq) = pack8_fp8(a[0], a[1]);
                asm volatile("" ::: "memory"); }
    }
};
struct Epi7 {
    static constexpr bool KHOOK = false, BEGIN = false, META = true;
    const float *LGATE, *BD; unsigned char* Y;
    __device__ __forceinline__ void meta_load(const UnitM& u, int par, LAS unsigned char* lds) const {
        if (threadIdx.x < 256) { const int slot = u.mtl * 256 + threadIdx.x;
            ((LAS float*)(lds + ROW_OFF))[par * 256 + threadIdx.x] = slot < u.cnt ? LGATE[u.e * LCAP + slot] * 16.0f : 0.f; }
    }
    __device__ __forceinline__ void bias_load(const UnitM& u, LAS unsigned char* lds) const {
        ((LAS f32x4*)(lds + BIAS_OFF))[threadIdx.x] = ((const f32x4*)(BD + (size_t)u.e * 2048))[threadIdx.x];
    }
    __device__ __forceinline__ void operator()(AccT& acc, const UnitM& u, int wr, int wc, int fr, int fq, int mseq, LAS unsigned char* lds) const {
        const int col = u.pn * 256 + 32 * wc + 8 * fq; const LAS float* bp = (const LAS float*)(lds + BIAS_OFF) + col; const LAS float* rowf = (const LAS float*)(lds + ROW_OFF) + (mseq & 1) * 256;
        const f32x4 b00 = *(const LAS f32x4*)bp, b01 = *(const LAS f32x4*)(bp + 4), b10 = *(const LAS f32x4*)(bp + 128), b11 = *(const LAS f32x4*)(bp + 132);
#pragma unroll
        for (int ai = 0; ai < 2; ++ai)
#pragma unroll
            for (int m = 0; m < 4; ++m) { const int slot = u.mtl * 256 + ROWL(ai, m); const float gt = rowf[ROWL(ai, m)];
                unsigned char* yp = Y + ((size_t)u.pstart + slot) * 2048 + col;
                *(u32x2*)yp = pack8_fp8((acc[ai][0][m][0] * 0.03125f + b00) * gt, (acc[ai][0][m][1] * 0.03125f + b01) * gt);
                *(u32x2*)(yp + 128) = pack8_fp8((acc[ai][1][m][0] * 0.03125f + b10) * gt, (acc[ai][1][m][1] * 0.03125f + b11) * gt);
                asm volatile("" ::: "memory"); }
    }
};

namespace att {
constexpr int SHM_V = 64 * 128 * 2;
__device__ __forceinline__ int v_st(int k, int c) { const int kk = (k & ~0xC) | ((k & 4) << 1) | ((k & 8) >> 1); return ((kk >> 3) * 4 + (c >> 5)) * 512 + ((kk & 7) * 32 + (c & 31)) * 2; }
__device__ __forceinline__ int v_rd_base(int lane) { return ((lane & 3) << 3) | (((lane >> 2) & 3) << 6) | (((lane >> 4) & 1) << 5) | (((lane >> 5) & 1) << 8); }
constexpr int v_rd_off(int d0, int ks, int half) { return d0 * 512 + ks * 4096 + half * 2048; }
__device__ __forceinline__ int crow(int r, int hi) { return (r & 3) + 8 * (r >> 2) + 4 * hi; }
__device__ __forceinline__ void mask_tile(f32x16& p0, f32x16& p1, int dq) {
    const float NEG = -__builtin_inff();
#pragma unroll
    for (int r = 0; r < 16; ++r) { const int c = (r & 3) + 8 * (r >> 2);
        if (dq - c < 0) p0[r] = NEG;
        if (dq - c - 32 < 0) p1[r] = NEG; }
}
template <int DK> __device__ __forceinline__ void partialSM(f32x16& p0, f32x16& p1, float& m_reg, float& mn, float& alpha) {
    constexpr float SCALE = DK == 192 ? 0.07216878364870322f : 0.08838834764831845f, THR = 8.f;
    float pmax = p0[0];
#pragma unroll
    for (int r = 1; r < 16; ++r) pmax = fmaxf(pmax, p0[r]);
#pragma unroll
    for (int r = 0; r < 16; ++r) pmax = fmaxf(pmax, p1[r]);
    { auto rr = __builtin_amdgcn_permlane32_swap(__float_as_uint(pmax), __float_as_uint(pmax), false, false);
      pmax = fmaxf(__uint_as_float(rr[0]), __uint_as_float(rr[1])); }
    constexpr float C2 = 1.4426950408889634f * SCALE;
    if (__builtin_expect(__all((pmax - m_reg) * SCALE <= THR), 1)) { mn = m_reg; alpha = 1.f; }
    else { mn = fmaxf(m_reg, pmax); alpha = __builtin_amdgcn_exp2f((m_reg - mn) * C2); m_reg = mn; }
    const float mnL = -mn * C2;
#pragma unroll
    for (int r = 0; r < 16; ++r) p0[r] = fmaf(p0[r], C2, mnL);
#pragma unroll
    for (int r = 0; r < 16; ++r) p1[r] = fmaf(p1[r], C2, mnL);
#pragma unroll
    for (int r = 0; r < 16; ++r) p0[r] = __builtin_amdgcn_exp2f(p0[r]);
}
__device__ __forceinline__ void finishSM(f32x16& p0, f32x16& p1, float alpha, float& l_reg, bf16x8& pa0, bf16x8& pa1, bf16x8& pa2, bf16x8& pa3) {
#pragma unroll
    for (int r = 0; r < 16; ++r) p1[r] = __builtin_amdgcn_exp2f(p1[r]);
    float ps = 0;
#pragma unroll
    for (int r = 0; r < 16; ++r) ps += p0[r];
#pragma unroll
    for (int r = 0; r < 16; ++r) ps += p1[r];
    { auto rr = __builtin_amdgcn_permlane32_swap(__float_as_uint(ps), __float_as_uint(ps), false, false);
      ps = __uint_as_float(rr[0]) + __uint_as_float(rr[1]); }
    l_reg = l_reg * alpha + ps;
#define PK4(P, B_, OUT) do { unsigned a0 = cvt_pk_bf16(P[B_+0], P[B_+1]), a1 = cvt_pk_bf16(P[B_+2], P[B_+3]);                          \
        unsigned b0 = cvt_pk_bf16(P[B_+4], P[B_+5]), b1 = cvt_pk_bf16(P[B_+6], P[B_+7]);                                             \
        auto r0 = __builtin_amdgcn_permlane32_swap(a0, b0, false, false); auto r1 = __builtin_amdgcn_permlane32_swap(a1, b1, false, false); \
        u32x4 w = {r0[0], r1[0], r0[1], r1[1]}; OUT = __builtin_bit_cast(bf16x8, w); } while (0)
    PK4(p0, 0, pa0); PK4(p0, 8, pa1); PK4(p1, 0, pa2); PK4(p1, 8, pa3);
#undef PK4
}
template <int DK, int KB>
__device__ __forceinline__ void qkt(f32x16& p0, f32x16& p1, const LAS unsigned char* K_lds, int r32, int hi, const bf16x8* qr) {
    constexpr int KROW = DK * 2, SHM_K = 64 * KROW;
    p0 = f32x16{}; p1 = f32x16{};
    const LAS unsigned char* kb[4];
#pragma unroll
    for (int dd = 0; dd < 4; ++dd) kb[dd] = K_lds + KB * SHM_K + r32 * KROW + (((dd * 16 + hi * 8) * 2) ^ ((r32 & 7) << 4));
#pragma unroll
    for (int d0 = 0; d0 < DK / 16; ++d0) { const LAS unsigned char* a = kb[d0 & 3] + (d0 >> 2) * 128;
        const bf16x8 b0 = *(const LAS bf16x8*)a;
        const bf16x8 b1 = *(const LAS bf16x8*)(a + 32 * KROW);
        p0 = __builtin_amdgcn_mfma_f32_32x32x16_bf16(b0, qr[d0], p0, 0, 0, 0);
        p1 = __builtin_amdgcn_mfma_f32_32x32x16_bf16(b1, qr[d0], p1, 0, 0, 0); }
}
template <int VB>
__device__ __forceinline__ void pv_tile(f32x16* o, int vb0, bf16x8 pa0, bf16x8 pa1, bf16x8 pa2, bf16x8 pa3) {
#define TRRD(dst, off) asm volatile("ds_read_b64_tr_b16 %0, %1 offset:%2" : "=&v"(dst) : "v"(vb0), "i"(off) : "memory")
#define PV_D0(d0) do { s16x4 l0, l1, l2, l3, h0, h1, h2, h3; constexpr int b_ = VB * SHM_V + v_rd_off(d0, 0, 0); \
        TRRD(l0, b_); TRRD(h0, b_ + 2048); TRRD(l1, b_ + 4096); TRRD(h1, b_ + 6144); TRRD(l2, b_ + 8192); TRRD(h2, b_ + 10240); TRRD(l3, b_ + 12288); TRRD(h3, b_ + 14336); \
        asm volatile("s_waitcnt lgkmcnt(0)" ::: "memory"); __builtin_amdgcn_sched_barrier(0);   \
        o[d0] = __builtin_amdgcn_mfma_f32_32x32x16_bf16(pa0, (bf16x8){l0[0], l0[1], l0[2], l0[3], h0[0], h0[1], h0[2], h0[3]}, o[d0], 0, 0, 0);   \
        o[d0] = __builtin_amdgcn_mfma_f32_32x32x16_bf16(pa1, (bf16x8){l1[0], l1[1], l1[2], l1[3], h1[0], h1[1], h1[2], h1[3]}, o[d0], 0, 0, 0);   \
        o[d0] = __builtin_amdgcn_mfma_f32_32x32x16_bf16(pa2, (bf16x8){l2[0], l2[1], l2[2], l2[3], h2[0], h2[1], h2[2], h2[3]}, o[d0], 0, 0, 0);   \
        o[d0] = __builtin_amdgcn_mfma_f32_32x32x16_bf16(pa3, (bf16x8){l3[0], l3[1], l3[2], l3[3], h3[0], h3[1], h3[2], h3[3]}, o[d0], 0, 0, 0); } while (0)
    PV_D0(0); PV_D0(1); PV_D0(2); PV_D0(3);
#undef PV_D0
#undef TRRD
}
template <int DK, bool CAUSAL>
__device__ __forceinline__ void attn_block(LAS unsigned char* lds, const bf16* Q, int qp, const bf16* Kn, int kp, const bf16* Kr, const bf16* V, int vp,
                                           bf16* O, int op, float* part, int P0, int NT) {
    constexpr int KROW = DK * 2, SHM_K = 64 * KROW, ND = DK / 16, NKP = SHM_K / 8192;
    const int tid = threadIdx.x, wid = __builtin_amdgcn_readfirstlane(tid >> 6), lane = tid & 63, r32 = lane & 31, hi = lane >> 5;
    LAS unsigned char* V_lds = lds; LAS unsigned char* K_lds = lds + 2 * SHM_V;
    LAS float* ws = (LAS float*)(lds + 2 * SHM_V + 2 * SHM_K) + wid * 64; LAS float* li_l = ws; LAS float* al_l = ws + 32;
    bf16x8 qr[ND];
#pragma unroll
    for (int d0 = 0; d0 < ND; ++d0) qr[d0] = *(const bf16x8*)(Q + (size_t)(wid * 32 + r32) * qp + d0 * 16 + hi * 8);
    unsigned koff[NKP], voff[2]; bool krope[NKP];
#pragma unroll
    for (int i = 0; i < NKP; ++i) { const int p = (wid * NKP + i) * 1024 + lane * 16, row = p / KROW, cpos = p - row * KROW, x = (row & 7) << 4;
        krope[i] = (DK == 192) && cpos >= 256;
        koff[i] = krope[i] ? (unsigned)(row * 128 + ((cpos - 256) ^ x)) : (unsigned)(row * kp * 2 + (cpos ^ x)); }
#pragma unroll
    for (int i = 0; i < 2; ++i) { const int p = (wid * 2 + i) * 1024 + lane * 16, sub = p >> 9, kk = (sub >> 2) * 8 + ((p & 511) >> 6), cc = (p & 63) >> 1;
        const int k = (kk & ~0xC) | ((kk & 4) << 1) | ((kk & 8) >> 1), c = (sub & 3) * 32 + cc;
        voff[i] = (unsigned)(k * vp * 2 + c * 2); }
    const int vb0 = (int)(unsigned)(uintptr_t)V_lds + v_rd_base(lane);
    const int qlo = P0 + wid * 32, qm = qlo + r32 - 4 * hi;
    float m_reg = -1e30f, l_reg = 0.f; f32x16 o[4] = {};
    f32x16 p0, p1; float mn, alpha; bf16x8 pa0, pa1, pa2, pa3;
#define AT_DMA(k0, bf) do { \
        _Pragma("unroll") for (int i_ = 0; i_ < NKP; ++i_) { const char* s_ = krope[i_] ? (const char*)Kr + (size_t)(k0) * 128 + koff[i_] : (const char*)Kn + (size_t)(k0) * kp * 2 + koff[i_]; \
            __builtin_amdgcn_global_load_lds((const unsigned*)s_, (LAS unsigned*)(K_lds + (bf) * SHM_K + (wid * NKP + i_) * 1024), 16, 0, 0); } \
        _Pragma("unroll") for (int i_ = 0; i_ < 2; ++i_) { const char* s_ = (const char*)V + (size_t)(k0) * vp * 2 + voff[i_]; \
            __builtin_amdgcn_global_load_lds((const unsigned*)s_, (LAS unsigned*)(V_lds + (bf) * SHM_V + (wid * 2 + i_) * 1024), 16, 0, 0); } } while (0)
#define AT_RESC(a) do { if (__any((a) < 1.f)) { if (hi == 0) al_l[r32] = (a); asm volatile("s_waitcnt lgkmcnt(0)" ::: "memory"); \
        _Pragma("unroll") for (int d_ = 0; d_ < 4; ++d_) _Pragma("unroll") for (int r = 0; r < 16; ++r) o[d_][r] *= al_l[crow(r, hi)]; } } while (0)
#define AT_STEP(t, B) do { asm volatile("s_waitcnt vmcnt(0)" ::: "memory"); __syncthreads(); \
        if ((t) + 1 < NT) AT_DMA(((t) + 1) * 64, 1 - (B)); \
        qkt<DK, B>(p0, p1, K_lds, r32, hi, qr); \
        if (CAUSAL) { const int kb_ = (t) * 64; if (kb_ + 63 > qlo) mask_tile(p0, p1, qm - kb_); } \
        partialSM<DK>(p0, p1, m_reg, mn, alpha); AT_RESC(alpha); finishSM(p0, p1, alpha, l_reg, pa0, pa1, pa2, pa3); __builtin_amdgcn_sched_barrier(0); \
        pv_tile<B>(o, vb0, pa0, pa1, pa2, pa3); } while (0)
    AT_DMA(0, 0);
    for (int t = 0; t < NT; t += 2) { AT_STEP(t, 0); AT_STEP(t + 1, 1); }
    if (hi == 0) li_l[r32] = l_reg; asm volatile("s_waitcnt lgkmcnt(0)" ::: "memory");
    bf16* Ow = O + (size_t)(wid * 32) * op; float* pw = part + wid * 32;
#pragma unroll
    for (int r = 0; r < 16; ++r) { const int orow = crow(r, hi); const float rli = __builtin_amdgcn_rcpf(li_l[orow]); float sq = 0.f;
#pragma unroll
        for (int d0 = 0; d0 < 4; ++d0) { const float v = o[d0][r] * rli; sq += v * v; const float vn = __shfl_xor(v, 1);
            if ((r32 & 1) == 0) *(unsigned*)(Ow + (size_t)orow * op + d0 * 32 + r32) = cvt_pk_bf16(v, vn); }
        sq += __shfl_xor(sq, 1); sq += __shfl_xor(sq, 2); sq += __shfl_xor(sq, 4); sq += __shfl_xor(sq, 8); sq += __shfl_xor(sq, 16);
        if (r32 == 0) pw[orow] = sq; }
    asm volatile("s_waitcnt vmcnt(0)" ::: "memory"); __syncthreads();
#undef AT_DMA
#undef AT_RESC
#undef AT_STEP
}
}

#define XB_TMO      128
#define XB_XCNT(j)  (256  + 64 * (j))
#define XB_XSUB(j)  (1280 + 64 * (j))
#define XB_XGEN(j)  (2304 + 64 * (j))
#define XB_TOP      3328
#define XB_TOPGEN   3392
#define XCD_BAR_WORDS 3456
#define XB_SPIN_CAP (1u << 18)
__device__ __forceinline__ unsigned xb_ld(unsigned* p)              { return __hip_atomic_load(p, __ATOMIC_RELAXED, __HIP_MEMORY_SCOPE_AGENT); }
__device__ __forceinline__ unsigned xb_add(unsigned* p, unsigned v) { return __hip_atomic_fetch_add(p, v, __ATOMIC_RELAXED, __HIP_MEMORY_SCOPE_AGENT); }
__device__ __forceinline__ unsigned xb_xcc_id() { return (unsigned)__builtin_amdgcn_s_getreg((3 << 11) | 20) & 0xFu; }
#define XB_SPIN(cond, bar) do { unsigned _sp = 0; while (cond) { __builtin_amdgcn_s_sleep(1); \
    if ((++_sp & 255u) == 0u) { if (xb_ld(&(bar)[XB_TMO])) break; if (_sp > XB_SPIN_CAP) { atomicAdd(&(bar)[XB_TMO], 1u); break; } } } } while (0)
struct XcdBarrier { unsigned* bar; unsigned x; volatile LAS unsigned* st; unsigned total; };
__device__ __forceinline__ XcdBarrier xcd_barrier_post(unsigned* bar, volatile LAS unsigned* st, unsigned total) {
    XcdBarrier b; b.bar = bar; b.x = xb_xcc_id(); b.st = st; b.total = total;
    if (threadIdx.x == 0) (void)xb_add(&bar[XB_XCNT(b.x)], 1u);
    return b;
}
__device__ __forceinline__ void xcd_barrier_complete(unsigned* bar, unsigned x, unsigned& nloc, unsigned& nx, const unsigned G) {
    unsigned sum, cnt, mine, sp = 0u;
    for (;;) {
        sum = 0u; cnt = 0u; mine = 0u;
#pragma unroll
        for (unsigned j = 0; j < 16; ++j) { const unsigned c = xb_ld(&bar[XB_XCNT(j)]); sum += c; cnt += (c > 0u) ? 1u : 0u; mine = (j == x) ? c : mine; }
        if (sum == G) break;
        __builtin_amdgcn_s_sleep(1);
        if ((++sp & 255u) == 0u) { if (xb_ld(&bar[XB_TMO])) break; if (sp > XB_SPIN_CAP) { atomicAdd(&bar[XB_TMO], 1u); break; } }
    }
    nloc = mine > 0u ? mine : 1u; nx = cnt > 0u ? cnt : 1u;
}
__device__ __forceinline__ void xcd_barrier(const XcdBarrier& b) {
    asm volatile("s_waitcnt vmcnt(0)" ::: "memory");
    __syncthreads();
    if (threadIdx.x == 0) {
        unsigned* bar = b.bar;
        __builtin_amdgcn_s_waitcnt(0);
        unsigned nloc = b.st[0], nx = b.st[1];
        if (nloc == 0u) { xcd_barrier_complete(bar, b.x, nloc, nx, b.total); b.st[0] = nloc; b.st[1] = nx; }
        const unsigned old = xb_add(&bar[XB_XSUB(b.x)], 1u);
        const unsigned gen = old / nloc;
        if (old + 1u == (gen + 1u) * nloc) {
            __builtin_amdgcn_fence(__ATOMIC_RELEASE, "agent");
            asm volatile("s_waitcnt vmcnt(0)" ::: "memory");
            const unsigned og = xb_add(&bar[XB_TOP], 1u);
            const unsigned tg = og / nx;
            if (og + 1u == (tg + 1u) * nx) xb_add(&bar[XB_TOPGEN], 1u);
            else XB_SPIN(xb_ld(&bar[XB_TOPGEN]) == tg, bar);
            __builtin_amdgcn_fence(__ATOMIC_ACQUIRE, "agent");
            xb_add(&bar[XB_XGEN(b.x)], 1u);
            asm volatile("s_waitcnt vmcnt(0)" ::: "memory");
        } else {
            XB_SPIN(xb_ld(&bar[XB_XGEN(b.x)]) == gen, bar);
            __builtin_amdgcn_fence(__ATOMIC_ACQUIRE, "agent");
            asm volatile("s_waitcnt vmcnt(0)" ::: "memory");
        }
    }
    __syncthreads();
}

struct InP { const LAS unsigned long long* T;
    __device__ __forceinline__ const float* operator[](int k) const { const unsigned long long v = T[k];
        const unsigned lo = __builtin_amdgcn_readfirstlane((unsigned)v), hi = __builtin_amdgcn_readfirstlane((unsigned)(v >> 32));
        return (const float*)(GAS const float*)(((unsigned long long)hi << 32) | lo); } };
__device__ __forceinline__ float tr_kgain(const InP& a, int mode, int k) {
    switch (mode) {
        case 0: return a[3][k];
        case 1: return a[16][k];
        case 2: return a[5][k];
        case 3: return a[7][k];
        case 4: return k < 1024 ? a[20][k] : (k < 1536 ? a[21][k - 1024] : a[22][k - 1536]);
        case 5: return a[24][k];
        default: return 1.0f;
    }
}
__device__ __forceinline__ void tr_mapn(const InP& a, int mode, int n, int& r, float& cg) {
    cg = 1.0f; r = n;
    switch (mode) {
        case 0:
            if (n < 1024) { r = n; }
            else if (n < 1088) { const int i = n - 1024; r = 2560 + (i < 32 ? i : 128 + (i - 32)); cg = a[12][i]; }
            else if (n < 2112) { r = 1024 + (n - 1088); }
            else { const int j = n - 2112; r = 2048 + j; cg = a[18][j & 127]; }
            break;
        case 1: if (n < 512) cg = a[19][n & 127]; break;
        case 2: { const int h = n / 192, d = n - h * 192;
            if (d < 128) { r = h * 128 + d; cg = a[9][d]; }
            else { const int i = d - 128; r = 1024 + (h >> 2) * 256 + (i < 32 ? 0 : 128) + (h & 3) * 32 + (i & 31); cg = a[10][i]; } } break;
        case 3: { const int h = n >> 8, d = n & 255;
            if (d < 128) { r = h * 128 + d; cg = a[11][d]; } else { r = 1024 + h * 128 + (d - 128); } } break;
        case 5: if (n < 2048) r = (n >> 7) * 256 + (n & 127); else { const int j = n - 2048; r = (j >> 7) * 256 + 128 + (j & 127); } break;
        default: break;
    }
}
__device__ __forceinline__ void tr_item(const InP& a, const float* W, int K, int N, bf16* WT, int mode, LAS float* scr, int item, int lane) {
    const int nblk = N >> 6, kb = item / nblk, nb = item - kb * nblk, k0 = kb << 6, n0 = nb << 6;
#pragma unroll 4
    for (int i = 0; i < 16; ++i) { const int kk = 4 * i + (lane >> 4), nn = (lane & 15) * 4;
        const f32x4 v = *(const f32x4*)(W + (size_t)(k0 + kk) * N + n0 + nn) * tr_kgain(a, mode, k0 + kk);
        LAS float* s = scr + kk * 65 + nn; s[0] = v[0]; s[1] = v[1]; s[2] = v[2]; s[3] = v[3]; }
    asm volatile("s_waitcnt lgkmcnt(0)" ::: "memory");
    const int c = lane & 7;
#pragma unroll
    for (int j = 0; j < 8; ++j) { const int n = (lane >> 3) + 8 * j; int r; float cg; tr_mapn(a, mode, n0 + n, r, cg);
        const LAS float* s = scr + (8 * c) * 65 + n;
        u32x4 o; o.x = cvt_pk_bf16(s[0] * cg, s[65] * cg); o.y = cvt_pk_bf16(s[130] * cg, s[195] * cg); o.z = cvt_pk_bf16(s[260] * cg, s[325] * cg); o.w = cvt_pk_bf16(s[390] * cg, s[455] * cg);
        *(u32x4*)(WT + (size_t)r * K + k0 + 8 * c) = o; }
    asm volatile("s_waitcnt lgkmcnt(0)" ::: "memory");
}
template <int MODE> __device__ __forceinline__ void tr8w_all(const float* Wsrc, unsigned char* Wdst, const float* gain, LAS unsigned char* lds, int bid, int G, int wave, int lane) {
    constexpr int N = MODE == 5 ? 4096 : 2048, NTN = N / 256, PER = 16 * NTN, NIT = 32 * PER, PITCH = 144, BUFB = 256 * PITCH;
    f32x4 vA[16], vB[16];
    int it = bid; if (it >= NIT) return;
#define TR8W_DECODE(IT, WB, OP, K0, N0) const int e_ = (IT) / PER, r_ = (IT) - e_ * PER, K0 = (r_ / NTN) * 128, N0 = (r_ % NTN) * 256; \
        const float* WB = Wsrc + (size_t)e_ * 2048 * N + (size_t)(K0 + 16 * wave) * N + N0; unsigned char* OP = Wdst + (size_t)e_ * N * 2048 + (size_t)(K0 >> 7) * 32768;
    const unsigned voff = (unsigned)lane * 16u;
#define TR8W_LOAD(V, IT) do { const int itc_ = (IT) < NIT ? (IT) : NIT - 1; TR8W_DECODE(itc_, wb_, op_, k0_, n0_); (void)op_; (void)n0_; (void)k0_; \
        _Pragma("unroll") for (int i = 0; i < 16; ++i) { const float* b_ = wb_ + (size_t)i * N; \
            asm volatile("global_load_dwordx4 %0, %1, %2 nt" : "=v"(V[i]) : "v"(voff), "s"(b_) : "memory"); } } while (0)
#define TR8W_WAIT(V) do { if (first) { if (&V[0] == &vA[0]) asm volatile("s_waitcnt vmcnt(16)" ::: "memory"); else asm volatile("s_waitcnt vmcnt(20)" ::: "memory"); } \
        else asm volatile("s_waitcnt vmcnt(24)" ::: "memory");                \
        _Pragma("unroll") for (int i = 0; i < 16; ++i) asm volatile("" : "+v"(V[i])); } while (0)
#define TR8W_PROC(V, IT, PAR) do { TR8W_DECODE(IT, wb, op, k0, n0); (void)wb; \
        unsigned pk[16]; (void)k0; (void)gain;                                 \
        TR8W_WAIT(V); \
        _Pragma("unroll") for (int i = 0; i < 16; ++i) { const f32x4 w = V[i] * 32.0f; \
            int t = __builtin_amdgcn_cvt_pk_fp8_f32(w[0], w[1], 0, false); t = __builtin_amdgcn_cvt_pk_fp8_f32(w[2], w[3], t, true); pk[i] = (unsigned)t; } \
        _Pragma("unroll") for (int i = 0; i < 16; ++i) asm volatile("" : "+v"(pk[i]));     \
        TR8W_LOAD(V, (IT) + 2 * G);                                           \
        u32x4 c[4]; \
        _Pragma("unroll") for (int bq = 0; bq < 4; ++bq) { const unsigned r0 = pk[4 * bq], r1 = pk[4 * bq + 1], r2 = pk[4 * bq + 2], r3 = pk[4 * bq + 3]; \
            const unsigned t0 = __builtin_amdgcn_perm(r1, r0, 0x05010400u), t1 = __builtin_amdgcn_perm(r1, r0, 0x07030602u); \
            const unsigned t2 = __builtin_amdgcn_perm(r3, r2, 0x05010400u), t3 = __builtin_amdgcn_perm(r3, r2, 0x07030602u); \
            c[0][bq] = __builtin_amdgcn_perm(t2, t0, 0x05040100u); c[1][bq] = __builtin_amdgcn_perm(t2, t0, 0x07060302u); \
            c[2][bq] = __builtin_amdgcn_perm(t3, t1, 0x05040100u); c[3][bq] = __builtin_amdgcn_perm(t3, t1, 0x07060302u); } \
        LAS unsigned char* T = lds + (PAR) * BUFB; \
        _Pragma("unroll") for (int j = 0; j < 4; ++j) *(LAS u32x4*)(T + (j * 64 + lane) * PITCH + 16 * wave) = c[j];     \
        asm volatile("s_waitcnt lgkmcnt(0)" ::: "memory"); __builtin_amdgcn_s_barrier(); asm volatile("" ::: "memory"); \
        _Pragma("unroll") for (int q = 0; q < 4; ++q) { const int slot = 32 * wave + 8 * q + (lane >> 3), ch = lane & 7, n = n0 + 4 * (slot & 63) + (slot >> 6); \
            const int r = (MODE == 5) ? (n < 2048 ? (n >> 7) * 256 + (n & 127) : ((n - 2048) >> 7) * 256 + 128 + ((n - 2048) & 127)) : n; \
            const u32x4 w = *(const LAS u32x4*)(T + slot * PITCH + 16 * ch); \
            __builtin_nontemporal_store(w, (u32x4*)(op + (size_t)(r >> 8) * 524288 + (size_t)(r & 255) * 128 + 16 * ch)); } } while (0)
    bool first = true;
    TR8W_LOAD(vA, it); TR8W_LOAD(vB, it + G);
    for (;;) {
        TR8W_PROC(vA, it, 0);
        if (it + G >= NIT) break;
        TR8W_PROC(vB, it + G, 1);
        if (it + 2 * G >= NIT) break;
        it += 2 * G; first = false;
    }
    asm volatile("s_waitcnt vmcnt(0)" ::: "memory");
#pragma unroll
    for (int i = 0; i < 16; ++i) asm volatile("" :: "v"(vA[i]), "v"(vB[i]));
    asm volatile("s_waitcnt lgkmcnt(0)" ::: "memory"); __builtin_amdgcn_s_barrier();
#undef TR8W_DECODE
#undef TR8W_LOAD
#undef TR8W_WAIT
#undef TR8W_PROC
}
__device__ __forceinline__ void row_cvt(const float* xrow, bf16* orow, float* rs, int lane) {
    const f32x4* xr = (const f32x4*)xrow + lane; f32x4 v[8]; float s = 0.f;
#pragma unroll
    for (int j = 0; j < 8; ++j) { v[j] = xr[64 * j]; s += dot4(v[j]); }
    s = wave_sum(s);
    if (lane == 0) *rs = rsqrtf(s * (1.0f / 2048.0f) + EPS);
    u32x2* o8 = (u32x2*)orow + lane;
#pragma unroll
    for (int j = 0; j < 8; ++j) { u32x2 w; w.x = cvt_pk_bf16(v[j][0], v[j][1]); w.y = cvt_pk_bf16(v[j][2], v[j][3]); o8[64 * j] = w; }
}

__global__ void __launch_bounds__(512, 2) fwd_kernel(Args args) {
    extern __shared__ __attribute__((aligned(16))) unsigned char lds_raw[];
    LAS unsigned char* lds = (LAS unsigned char*)lds_raw;
    const int tid = threadIdx.x, lane = tid & 63, wave = __builtin_amdgcn_readfirstlane(tid >> 6);
    const int G = gridDim.x, bid = blockIdx.x;
    unsigned* ctl = (unsigned*)(GAS unsigned*)(args.ws + WS_CTL);
    GAS unsigned char* wsg = (GAS unsigned char*)args.ws;
#define wsp ((unsigned char*)wsg)
#define LAUNDER_WS() asm volatile("" : "+s"(wsg))
#define W1T ((bf16*)(wsp + WS_W1T))
#define WMKVT ((bf16*)(wsp + WS_WMKVT))
#define WQBT ((bf16*)(wsp + WS_WQBT))
#define WKVBT ((bf16*)(wsp + WS_WKVBT))
#define WOT ((bf16*)(wsp + WS_WOT))
#define WSP ((bf16*)(wsp + WS_WSP))
#define WR4 ((float*)(wsp + WS_WR4))
#define WGUT ((unsigned char*)(wsp + WS_WGUT))
#define WDT ((unsigned char*)(wsp + WS_WDT))
#define XB ((bf16*)(wsp + WS_XB))
#define MEMB ((bf16*)(wsp + WS_MEMB))
#define RSTDX ((float*)(wsp + WS_RSTDX))
#define RSTDM ((float*)(wsp + WS_RSTDM))
#define ROPEC ((float*)(wsp + WS_ROPEC))
#define ROPES ((float*)(wsp + WS_ROPES))
#define CQ ((bf16*)(wsp + WS_CQ))
#define CKV ((bf16*)(wsp + WS_CKV))
#define U ((bf16*)(wsp + WS_U))
#define VG ((bf16*)(wsp + WS_VG))
#define QM ((bf16*)(wsp + WS_QM))
#define KPE ((bf16*)(wsp + WS_KPE))
#define MK ((bf16*)(wsp + WS_MK))
#define MV ((bf16*)(wsp + WS_MV))
#define PARTQ ((float*)(wsp + WS_PARTQ))
#define PARTKV ((float*)(wsp + WS_PARTKV))
#define PARTVG ((float*)(wsp + WS_PARTVG))
#define PARTA ((float*)(wsp + WS_PARTA))
#define PARTB ((float*)(wsp + WS_PARTB))
#define PARTM ((float*)(wsp + WS_PARTM))
#define PARTF ((float*)(wsp + WS_PARTF))
#define QBUF ((bf16*)(wsp + WS_QBUF))
#define KBUF ((bf16*)(wsp + WS_KBUF))
#define VBUF ((bf16*)(wsp + WS_VBUF))
#define OC ((bf16*)(wsp + WS_OC))
#define XQ1 ((unsigned char*)(wsp + WS_XB1))
#define LTOK ((int*)(wsp + WS_LTOK))
#define LRS ((float*)(wsp + WS_LRS))
#define LGATE ((float*)(wsp + WS_LGATE))
#define SEL ((int*)(wsp + WS_SEL))
#define ACT ((unsigned char*)(wsp + WS_ACT))
#define Y ((unsigned char*)(wsp + WS_Y))
    float* X1 = (float*)(GAS float*)args.out;

    for (int u = tid; u < 64; u += 512) ((LAS unsigned*)(lds + MISC_OFF))[u] = 0u;
    if (tid < 31) ((LAS unsigned long long*)(lds + PT_OFF))[tid] = (unsigned long long)args.in[tid];
    __syncthreads();
    const InP INP{(const LAS unsigned long long*)(lds + PT_OFF)};
    const int NCONV = (G == 256) ? 64 : 0;
    const bool is_conv = NCONV != 0 && ((bid >> 3) & 3) == 3;
    const int Gc = G - NCONV, cidx = NCONV ? (bid >> 5) * 24 + (bid & 31) : bid, vidx = (bid >> 5) * 8 + (bid & 7);
    XcdBarrier bar = xcd_barrier_post(ctl + CW_BAR, (volatile LAS unsigned*)(lds + MISC_OFF) + 8, (unsigned)G);
    XcdBarrier barc = bar;
    if (NCONV && !is_conv) barc = xcd_barrier_post(ctl + CW_BAR + XCD_BAR_WORDS, (volatile LAS unsigned*)(lds + MISC_OFF) + 12, (unsigned)Gc);
    const int lo = args.ph_lo, hi = args.ph_hi;
#ifndef PHASE_MASK
#define PHASE_MASK 0x1ff
#endif
#define IN(k) (((PHASE_MASK >> (k)) & 1) && lo <= (k) && (k) < hi)
#define SEAM(k) do { if (IN(k) && IN((k) + 1)) { if (NCONV && (k) >= 1 && (k) <= 3) { if (!is_conv) xcd_barrier(barc); } else xcd_barrier(bar); } } while (0)

    if (IN(0)) REPS(0) {
        LAUNDER_WS();
        LAS float* scr = (LAS float*)(lds + wave * 16640);
        const int gw = bid * 8 + wave, NGW = G * 8;
        if (!NCONV) { tr8w_all<5>(INP[27], WGUT, INP[24], lds, bid, G, wave, lane); tr8w_all<6>(INP[29], WDT, INP[24], lds, bid, G, wave, lane); }
        for (int it = gw; it < 1312 + 512 + 192 + 256 + 1024; it += NGW) {
            int r = it;
            if (r < 1312) { tr_item(INP, INP[4], 2048, 2624, W1T, 0, scr, r, lane); continue; } r -= 1312;
            if (r < 512) { tr_item(INP, INP[17], 2048, 1024, WMKVT, 1, scr, r, lane); continue; } r -= 512;
            if (r < 192) { tr_item(INP, INP[6], 512, 1536, WQBT, 2, scr, r, lane); continue; } r -= 192;
            if (r < 256) { tr_item(INP, INP[8], 512, 2048, WKVBT, 3, scr, r, lane); continue; } r -= 256;
            tr_item(INP, INP[23], 2048, 2048, WOT, 4, scr, r, lane);
        }
        for (int it = gw; it < 192; it += NGW) { const int rr = it < 96 ? 32 + it : 160 + (it - 96); u32x4* p = (u32x4*)(W1T + (size_t)(2560 + rr) * 2048) + lane;
#pragma unroll
            for (int j = 0; j < 4; ++j) p[64 * j] = (u32x4){0u, 0u, 0u, 0u}; }
        for (int m = gw; m < NTOK; m += NGW) row_cvt(INP[0] + (size_t)m * 2048, XB + (size_t)m * 2048, RSTDX + m, lane);
        for (int m = gw; m < NMROWS; m += NGW) row_cvt(INP[1] + (size_t)m * 2048, MEMB + (size_t)m * 2048, RSTDM + m, lane);
        const int gt = bid * 512 + tid, NGT = G * 512;
        for (int i = gt; i < NTOK * 32; i += NGT) { const int tok = i >> 5, j = i & 31; const float ang = (float)((const int*)INP[2])[tok] * args.invf[j];
            ROPEC[i] = cosf(ang); ROPES[i] = sinf(ang); }
        for (int i = gt; i < 4 * 128 * 128; i += NGT) { const int t = (i >> 7) & 127, s = i & 127; const float w = s <= t ? INP[14][i] : 0.f; WSP[i] = (bf16)(cvt_pk_bf16(w, 0.f) & 0xffffu); }
        for (int i = gt; i < 2048 * 32; i += NGT) { const int k = i >> 5, n = i & 31; WR4[(((k >> 4) * 2 + ((k >> 3) & 1)) * 32 + n) * 8 + (k & 7)] = INP[25][i] * INP[24][k]; }
    }
    SEAM(0);

    if (IN(1) && is_conv) {
        LAUNDER_WS();
        tr8w_all<5>(INP[27], WGUT, INP[24], lds, vidx, NCONV, wave, lane); tr8w_all<6>(INP[29], WDT, INP[24], lds, vidx, NCONV, wave, lane);
    }
    if (IN(1) && !is_conv) REPS(1) {
        LAUNDER_WS();
        Sched1 S{Gc, cidx, XB, W1T, MEMB, WMKVT};
        Epi1 E{RSTDX, RSTDM, ROPEC, ROPES, CQ, CKV, U, VG, QM, KPE, MK, MV, PARTQ, PARTKV, PARTVG};
        pg8::gemm_phase<Epi1, Sched1, false, false>(lds, 32, 4096, 128, 4096, 128, S, E);
    }
    SEAM(1);

    if (IN(2) && !is_conv) REPS(2) {
        LAUNDER_WS();
#ifndef P2_PARTS
#define P2_PARTS 7
#endif
        if (P2_PARTS & 1) { Sched2 S{Gc, cidx, CQ, CKV, WQBT, WKVBT};
          Epi2 E{PARTQ, PARTKV, ROPEC, ROPES, QBUF, KBUF, VBUF};
          pg8::gemm_phase<Epi2, Sched2, false, false>(lds, 8, 1024, 128, 1024, 128, S, E); }
        if (P2_PARTS & 2) {
            LAS unsigned short* T = (LAS unsigned short*)lds;
            LAS float* rsl = (LAS float*)(lds + 40960);
            const int wq = wave & 3, tb = (wave >> 2) * 64, fr = lane & 15, fq = lane >> 4;
            const int p4 = tid & 31, cch = tid >> 5;
            for (int unit = Gc - 1 - cidx; unit < 512; unit += Gc) {
                const int g = unit & 3, cn = unit >> 2, row0 = cn * 128;
                u32x4 vr[4];
#pragma unroll
                for (int r = 0; r < 4; ++r) vr[r] = *(const u32x4*)(VG + (size_t)(row0 + 4 * p4 + r) * 512 + g * 128 + 8 * cch);
                bf16x8 af[4][4];
#pragma unroll
                for (int ks = 0; ks < 4; ++ks)
#pragma unroll
                    for (int m = 0; m < 4; ++m) af[ks][m] = *(const bf16x8*)(WSP + (size_t)(g * 128 + tb + 16 * m + fr) * 128 + ks * 32 + 8 * fq);
                u32x2 uw[4][2]; float bs[4]; f32x4 gv[2];
#pragma unroll
                for (int m = 0; m < 4; ++m) { bs[m] = INP[15][g * 128 + tb + 16 * m + fr];
#pragma unroll
                    for (int n = 0; n < 2; ++n) uw[m][n] = *(const u32x2*)(U + (size_t)(row0 + tb + 16 * m + fr) * 512 + g * 128 + wq * 32 + 16 * n + 4 * fq); }
#pragma unroll
                for (int n = 0; n < 2; ++n) gv[n] = *(const f32x4*)(INP[13] + g * 128 + wq * 32 + 16 * n + 4 * fq);
                if (tid < 128) { float s = 0.f;
#pragma unroll
                    for (int k = 0; k < 8; ++k) s += PARTVG[(size_t)k * NTOK + row0 + tid];
                    rsl[tid] = rsqrtf(s * (1.0f / 512.0f) + EPS); }
                __syncthreads();
                { const f32x4 rs = *(const LAS f32x4*)(rsl + 4 * p4); unsigned nw[4][4];
#pragma unroll
                  for (int r = 0; r < 4; ++r)
#pragma unroll
                    for (int j = 0; j < 4; ++j) { const unsigned x = vr[r][j]; nw[r][j] = cvt_pk_bf16(__uint_as_float(x << 16) * rs[r], __uint_as_float(x & 0xffff0000u) * rs[r]); }
#pragma unroll
                  for (int j = 0; j < 4; ++j) {
                    u32x2 lo, hi;
                    lo.x = __builtin_amdgcn_perm(nw[1][j], nw[0][j], 0x05040100u); lo.y = __builtin_amdgcn_perm(nw[3][j], nw[2][j], 0x05040100u);
                    hi.x = __builtin_amdgcn_perm(nw[1][j], nw[0][j], 0x07060302u); hi.y = __builtin_amdgcn_perm(nw[3][j], nw[2][j], 0x07060302u);
                    *(LAS u32x2*)(T + (8 * cch + 2 * j) * 136 + 4 * p4) = lo; *(LAS u32x2*)(T + (8 * cch + 2 * j + 1) * 136 + 4 * p4) = hi; } }
                __syncthreads();
                f32x4 acc[4][2];
#pragma unroll
                for (int m = 0; m < 4; ++m) { acc[m][0] = (f32x4){0.f, 0.f, 0.f, 0.f}; acc[m][1] = (f32x4){0.f, 0.f, 0.f, 0.f}; }
#pragma unroll
                for (int ks = 0; ks < 4; ++ks) {
                    bf16x8 bfr[2];
#pragma unroll
                    for (int n = 0; n < 2; ++n) bfr[n] = *(const LAS bf16x8*)(T + (wq * 32 + 16 * n + fr) * 136 + ks * 32 + 8 * fq);
#pragma unroll
                    for (int m = 0; m < 4; ++m)
#pragma unroll
                        for (int n = 0; n < 2; ++n) acc[m][n] = __builtin_amdgcn_mfma_f32_16x16x32_bf16(bfr[n], af[ks][m], acc[m][n], 0, 0, 0);
                }
#pragma unroll
                for (int m = 0; m < 4; ++m) { const int t = tb + 16 * m + fr, row = row0 + t; float ss = 0.f;
#pragma unroll
                    for (int n = 0; n < 2; ++n) { const int c = g * 128 + wq * 32 + 16 * n + 4 * fq;
                        const u32x2 w2 = uw[m][n];
                        const f32x4 uv = {__uint_as_float(w2.x << 16), __uint_as_float(w2.x & 0xffff0000u), __uint_as_float(w2.y << 16), __uint_as_float(w2.y & 0xffff0000u)};
                        const f32x4 ov = uv * (acc[m][n] * gv[n] + bs[m]); ss += dot4(ov);
                        u32x2 w; w.x = cvt_pk_bf16(ov[0], ov[1]); w.y = cvt_pk_bf16(ov[2], ov[3]); *(u32x2*)(OC + (size_t)row * 2048 + 1024 + c) = w; }
                    ss = red4(ss); if (fq == 0) PARTB[(size_t)(g * 4 + wq) * NTOK + row] = ss; }
                __syncthreads();
            }
        }
        if (P2_PARTS & 4) for (int it = Gc - 1 - cidx; it < 256; it += Gc) {
            const int bh = (it & 7) * 2 + ((it >> 3) >> 4), qb = (it >> 3) & 15, b = bh >> 2, h = bh & 3; const size_t r0 = (size_t)b * SEQ + qb * 256;
            att::attn_block<128, false>(lds, QM + r0 * 512 + h * 128, 512, MK + (size_t)b * NMEM * 512 + h * 128, 512, nullptr, MV + (size_t)b * NMEM * 512 + h * 128, 512,
                                        OC + r0 * 2048 + 1536 + h * 128, 2048, PARTM + (size_t)h * NTOK + r0, 0, 4);
        }
    }
    SEAM(2);

    if (IN(3) && !is_conv) REPS(3) {
        LAUNDER_WS();
        unsigned pat; int nblk;
        if (Gc == 192) { const int p = cidx >> 5;
            pat = p == 0 ? 0x23Fu : p == 1 ? 0x7Eu : p == 2 ? 0x8Du : p == 3 ? 0x9Cu : p == 4 ? 0xABu : 0x01456u;
            nblk = p == 0 ? 3 : p == 5 ? 5 : 2; }
        else { pat = 0u; nblk = (512 + Gc - 1) / Gc; }
#pragma unroll 1
        for (int r = 0; r < nblk; ++r) {
            int qb, bh;
            if (Gc == 192) { qb = (int)((pat >> (4 * r)) & 15u); bh = cidx & 31; }
            else { const int i = r * Gc + ((r & 1) ? Gc - 1 - cidx : cidx); if (i >= 512) continue; qb = 15 - (i >> 5); bh = i & 31; }
            const int b = bh >> 3, h = bh & 7; const size_t r0 = (size_t)b * SEQ + qb * 256;
            att::attn_block<192, true>(lds, QBUF + r0 * 1536 + h * 192, 1536, KBUF + (size_t)b * SEQ * 1024 + h * 128, 1024, KPE + (size_t)b * SEQ * 64,
                                       VBUF + (size_t)b * SEQ * 1024 + h * 128, 1024, OC + r0 * 2048 + h * 128, 2048, PARTA + (size_t)h * NTOK + r0, qb * 256, qb * 4 + 4);
        }
    }
    SEAM(3);

    const bool p4all = NCONV == 64 && IN(3) && IN(4);
    if (p4all && !is_conv && cidx == 0 && tid == 0) __hip_atomic_store(ctl + CW_P3DONE, 1u, __ATOMIC_RELEASE, __HIP_MEMORY_SCOPE_AGENT);
    if (p4all && is_conv) {
        if (tid == 0) { unsigned sp = 0u; while (__hip_atomic_load(ctl + CW_P3DONE, __ATOMIC_RELAXED, __HIP_MEMORY_SCOPE_AGENT) == 0u && ++sp < (1u << 24)) __builtin_amdgcn_s_sleep(2);
            __builtin_amdgcn_fence(__ATOMIC_ACQUIRE, "agent"); }
        __syncthreads();
    }
    if (IN(4) && (!is_conv || p4all)) REPS(4) {
        LAUNDER_WS();
        Sched4 S{p4all ? (is_conv ? 64 : 192) : Gc, p4all && is_conv ? 384 + vidx : cidx, p4all ? 2 : 1 << 20, OC, WOT};
        Epi4 E{PARTA, PARTB, PARTM, INP[24], XB, PARTF, XQ1};
        pg8::gemm_phase<Epi4, Sched4, false, false>(lds, 32, 4096, 128, 4096, 128, S, E);
    }
    SEAM(4);

    if (IN(5) && DBG_LAST_PHASE >= 5) {
        LAUNDER_WS();
        LAS float* LG = (LAS float*)lds;
        LAS int* hist = (LAS int*)(lds + 65536); LAS int* base = hist + 32;
        const int r32 = lane & 31, hi5 = lane >> 5, kq = wave;
        for (int tg = bid; tg < NTOK / 32; tg += G) {
            const int tok0 = tg * 32;
            if (tid < 32) hist[tid] = 0;
            f32x16 acc = {};
            const bf16* xp = XB + (size_t)(tok0 + r32) * 2048 + kq * 256 + 8 * hi5;
            const float* wp = WR4 + ((size_t)(kq * 16 * 2 + hi5) * 32 + r32) * 8;
#pragma unroll 4
            for (int s = 0; s < 16; ++s) { const u32x4 aw = *(const u32x4*)(xp + 16 * s); const f32x4 b0 = *(const f32x4*)(wp + (size_t)s * 512), b1 = *(const f32x4*)(wp + (size_t)s * 512 + 4);
#pragma unroll
                for (int j = 0; j < 4; ++j) { acc = __builtin_amdgcn_mfma_f32_32x32x2f32(__uint_as_float(aw[j] << 16), j < 2 ? b0[2 * j] : b1[2 * j - 4], acc, 0, 0, 0);
                    acc = __builtin_amdgcn_mfma_f32_32x32x2f32(__uint_as_float(aw[j] & 0xffff0000u), j < 2 ? b0[2 * j + 1] : b1[2 * j - 3], acc, 0, 0, 0); } }
#pragma unroll
            for (int r = 0; r < 16; ++r) LG[(kq * 32 + att::crow(r, hi5)) * 33 + r32] = acc[r];
            __syncthreads();
            int se[4] = {0, 0, 0, 0}, sl[4] = {0, 0, 0, 0}; float gate[4] = {0.f, 0.f, 0.f, 0.f}, rs2 = 0.f;
            if (tid < 32) {
                const int tok = tok0 + tid, tl = tid; float ssum = 0.f;
#pragma unroll
                for (int k = 0; k < 32; ++k) ssum += PARTF[(size_t)k * NTOK + tok];
                rs2 = rsqrtf(ssum * (1.0f / 2048.0f) + EPS);
                float v[32];
#pragma unroll
                for (int e = 0; e < 32; ++e) { float s = 0.f;
#pragma unroll
                    for (int q = 0; q < 8; ++q) s += LG[(q * 32 + tl) * 33 + e];
                    v[e] = s * rs2 + INP[26][e]; }
                float tv[4];
#pragma unroll
                for (int k = 0; k < 4; ++k) { float best = -__builtin_inff(); int bi = 0;
#pragma unroll
                    for (int e = 0; e < 32; ++e) if (v[e] > best) { best = v[e]; bi = e; }
#pragma unroll
                    for (int e = 0; e < 32; ++e) v[e] = (e == bi) ? -__builtin_inff() : v[e];
                    se[k] = bi; tv[k] = best; }
                float den = 0.f;
#pragma unroll
                for (int k = 0; k < 4; ++k) { gate[k] = __expf(tv[k] - tv[0]); den += gate[k]; }
                const float inv = 1.0f / den;
#pragma unroll
                for (int k = 0; k < 4; ++k) { gate[k] *= inv; sl[k] = __hip_atomic_fetch_add(hist + se[k], 1, __ATOMIC_RELAXED, __HIP_MEMORY_SCOPE_WORKGROUP); }
            }
            __syncthreads();
            if (tid < 32) { const int hcnt = hist[tid]; base[tid] = hcnt > 0 ? (int)__hip_atomic_fetch_add(ctl + CW_CNT + 64 * tid, (unsigned)hcnt, __ATOMIC_RELAXED, __HIP_MEMORY_SCOPE_AGENT) : 0; }
            __syncthreads();
            if (tid < 32) { const int tok = tok0 + tid;
#pragma unroll
                for (int k = 0; k < 4; ++k) { const int e = se[k], slot = base[e] + sl[k]; LTOK[e * LCAP + slot] = tok; LRS[e * LCAP + slot] = rs2; LGATE[e * LCAP + slot] = gate[k]; SEL[tok * 4 + k] = e * LCAP + slot; } }
            __syncthreads();
        }
    }
    SEAM(5);

#define MOE_TABLES() do { LAS int* T_ = (LAS int*)(lds + MOE_OFF); if (tid < 64) { const int e_ = lane & 31; \
        const int c_ = (int)__hip_atomic_load(ctl + CW_CNT + 64 * e_, __ATOMIC_RELAXED, __HIP_MEMORY_SCOPE_AGENT); int nt_ = (c_ + 255) >> 8, inc_ = nt_; \
        _Pragma("unroll") for (int o_ = 1; o_ < 32; o_ <<= 1) { const int v_ = __shfl_up(inc_, o_); if (e_ >= o_) inc_ += v_; } \
        if (tid < 32) { T_[e_ + 1] = inc_; T_[64 + e_] = (inc_ - nt_) * 256; T_[128 + e_] = c_; if (e_ == 0) T_[0] = 0; } } __syncthreads(); } while (0)

    if (IN(6) && DBG_LAST_PHASE >= 6) REPS(6) {
        LAUNDER_WS();
        MOE_TABLES();
        SchedM<true> S{G, bid, (const LAS int*)(lds + MOE_OFF), XQ1, WGUT, LTOK};
        Epi6 E{LRS, INP[28], ACT};
        pg8::gemm_phase<Epi6, SchedM<true>, true, true>(lds, 16, 2048, 128, 128, 32768, S, E);
    }
    SEAM(6);

    if (IN(7) && DBG_LAST_PHASE >= 7) REPS(7) {
        LAUNDER_WS();
        MOE_TABLES();
        SchedM<false> S{G, bid, (const LAS int*)(lds + MOE_OFF), ACT, WDT, LTOK};
        Epi7 E{LGATE, INP[30], Y};
        pg8::gemm_phase<Epi7, SchedM<false>, true, true>(lds, 16, 128, 32768, 128, 32768, S, E);
    }
    SEAM(7);

    if (IN(8) && DBG_LAST_PHASE >= 8) {
        LAUNDER_WS();
        MOE_TABLES();
        const LAS int* T = (const LAS int*)(lds + MOE_OFF);
        const int gw = bid * 8 + wave, NGW = G * 8;
        for (int tok = gw; tok < NTOK; tok += NGW) {
            const int4 sel = *(const int4*)(SEL + tok * 4); size_t yr[4];
            yr[0] = (size_t)(T[64 + (sel.x >> 14)] + (sel.x & (LCAP - 1))) * 2048; yr[1] = (size_t)(T[64 + (sel.y >> 14)] + (sel.y & (LCAP - 1))) * 2048;
            yr[2] = (size_t)(T[64 + (sel.z >> 14)] + (sel.z & (LCAP - 1))) * 2048; yr[3] = (size_t)(T[64 + (sel.w >> 14)] + (sel.w & (LCAP - 1))) * 2048;
            u32x4 yw[2][4], xw[2][2];
#pragma unroll
            for (int j = 0; j < 2; ++j) {
#pragma unroll
                for (int k = 0; k < 4; ++k) yw[j][k] = *((const u32x4*)(Y + yr[k] + 1024 * j) + lane);
#pragma unroll
                for (int q = 0; q < 2; ++q) xw[j][q] = *((const u32x4*)(XB + (size_t)tok * 2048 + 1024 * j + 16 * lane) + q); }
#pragma unroll
            for (int j = 0; j < 2; ++j)
#pragma unroll
                for (int q = 0; q < 4; ++q) { const unsigned x01 = xw[j][q >> 1][(q & 1) * 2], x23 = xw[j][q >> 1][(q & 1) * 2 + 1];
                    f32x4 v = {__uint_as_float(x01 << 16), __uint_as_float(x01 & 0xffff0000u), __uint_as_float(x23 << 16), __uint_as_float(x23 & 0xffff0000u)};
#pragma unroll
                    for (int k = 0; k < 4; ++k) { const int w = (int)yw[j][k][q];
                        v += (f32x4){__builtin_amdgcn_cvt_f32_fp8(w, 0), __builtin_amdgcn_cvt_f32_fp8(w, 1), __builtin_amdgcn_cvt_f32_fp8(w, 2), __builtin_amdgcn_cvt_f32_fp8(w, 3)} * 0.0625f; }
                    *((f32x4*)(X1 + (size_t)tok * 2048 + 1024 * j + 16 * lane) + q) = v; }
        }
    }
#undef IN
#undef SEAM
#undef W1T
#undef WMKVT
#undef WQBT
#undef WKVBT
#undef WOT
#undef WSP
#undef WR4
#undef WGUT
#undef WDT
#undef XB
#undef MEMB
#undef RSTDX
#undef RSTDM
#undef ROPEC
#undef ROPES
#undef CQ
#undef CKV
#undef U
#undef VG
#undef QM
#undef KPE
#undef MK
#undef MV
#undef PARTQ
#undef PARTKV
#undef PARTVG
#undef PARTA
#undef PARTB
#undef PARTM
#undef PARTF
#undef QBUF
#undef KBUF
#undef VBUF
#undef OC
#undef XQ1
#undef LTOK
#undef LRS
#undef LGATE
#undef SEL
#undef ACT
#undef Y
}

extern "C" void kernel_launch(void* const* d_in, const int* in_sizes, int n_in, void* d_out, int out_size, void* d_ws, size_t ws_size, hipStream_t stream) {
    static int grid = 0;
    if (grid == 0) {
        if (n_in != 31 || out_size != NTOK * DM || ws_size < WS_END) { fprintf(stderr, "kernel_launch: unexpected shapes (n_in %d out %d ws %zu need %zu)\n", n_in, out_size, ws_size, (size_t)WS_END); grid = -1; return; }
        int dev = 0, cus = 0;
        if (hipGetDevice(&dev) != hipSuccess || hipDeviceGetAttribute(&cus, hipDeviceAttributeMultiprocessorCount, dev) != hipSuccess) { grid = -1; return; }
        if (hipFuncSetAttribute((const void*)fwd_kernel, hipFuncAttributeMaxDynamicSharedMemorySize, LDS_BYTES) != hipSuccess) { fprintf(stderr, "kernel_launch: hipFuncSetAttribute failed\n"); grid = -1; return; }
        int per_cu = 0;
        if (hipOccupancyMaxActiveBlocksPerMultiprocessor(&per_cu, (const void*)fwd_kernel, 512, LDS_BYTES) != hipSuccess || per_cu < 1) { fprintf(stderr, "kernel_launch: occupancy query says %d\n", per_cu); }
        (void)hipGetLastError();
        grid = cus > 0 ? cus : 256;
    }
    if (grid < 0) return;
    (void)hipMemsetAsync((char*)d_ws + WS_CTL, 0, CTL_BYTES, stream);
    Args a{};
    for (int i = 0; i < 31; ++i) a.in[i] = (const float*)d_in[i];
    a.out = (float*)d_out; a.ws = (unsigned char*)d_ws;
    for (int i = 0; i < 32; ++i) a.invf[i] = powf(10000.0f, -(float)i / 32.0f);
#if MK_N_LAUNCHES == 1
    a.ph_lo = 0; a.ph_hi = NPHASE;
    hipLaunchKernelGGL(fwd_kernel, dim3(grid), dim3(512), LDS_BYTES, stream, a);
#else
    for (int p = 0; p < NPHASE; ++p) { a.ph_lo = p; a.ph_hi = p + 1; hipLaunchKernelGGL(fwd_kernel, dim3(grid), dim3(512), LDS_BYTES, stream, a); }
#endif
}
```

```cpp
#include <hip/hip_runtime.h>
#include <cstdio>
#include <cstdint>
#include <cmath>

#ifndef MK_N_LAUNCHES
#define MK_N_LAUNCHES 1
#endif
#ifndef DBG_LAST_PHASE
#define DBG_LAST_PHASE 9
#endif
#ifndef DUP_PHASE
#define DUP_PHASE -1
#endif
#define REPS(k) for (int rep_ = 0; rep_ < ((DUP_PHASE == (k)) ? 2 : 1); ++rep_)

#define GAS __attribute__((address_space(1)))
#define LAS __attribute__((address_space(3)))
typedef unsigned short bf16;
typedef short bf16x8 __attribute__((ext_vector_type(8)));
typedef short s16x4 __attribute__((ext_vector_type(4)));
typedef float f32x2 __attribute__((ext_vector_type(2)));
typedef float f32x4 __attribute__((ext_vector_type(4)));
typedef float f32x16 __attribute__((ext_vector_type(16)));
typedef unsigned u32x2 __attribute__((ext_vector_type(2)));
typedef unsigned u32x4 __attribute__((ext_vector_type(4)));
typedef int i32x4 __attribute__((ext_vector_type(4)));
typedef int i32x8 __attribute__((ext_vector_type(8)));

constexpr int NB = 4, SEQ = 4096, DM = 2048, NTOK = NB * SEQ;
constexpr int NMEM = 256, NMROWS = NB * NMEM;
constexpr int N1 = 2816;
constexpr int NE = 32, LCAP = 16384;
constexpr int PMAX = 73728;
constexpr float EPS = 1e-6f;
constexpr int NPHASE = 9;

constexpr size_t al256(size_t x) { return (x + 255) & ~(size_t)255; }
constexpr size_t WS_CTL = 0, CTL_BYTES = 1u << 20;
constexpr size_t WS_W1T = CTL_BYTES;
constexpr size_t WS_WMKVT = WS_W1T + al256((size_t)N1 * 2048 * 2);
constexpr size_t WS_WQBT = WS_WMKVT + al256((size_t)1024 * 2048 * 2);
constexpr size_t WS_WKVBT = WS_WQBT + al256((size_t)1536 * 512 * 2);
constexpr size_t WS_WOT = WS_WKVBT + al256((size_t)2048 * 512 * 2);
constexpr size_t WS_WSP = WS_WOT + al256((size_t)2048 * 2048 * 2);
constexpr size_t WS_WR4 = WS_WSP + al256((size_t)4 * 128 * 128 * 2);
constexpr size_t WS_WGUT = WS_WR4 + al256((size_t)2048 * 32 * 4);
constexpr size_t WS_WDT = WS_WGUT + al256((size_t)NE * 4096 * 2048);
constexpr size_t WS_XB = WS_WDT + al256((size_t)NE * 2048 * 2048);
constexpr size_t WS_MEMB = WS_XB + al256((size_t)NTOK * 2048 * 2);
constexpr size_t WS_RSTDX = WS_MEMB + al256((size_t)NMROWS * 2048 * 2);
constexpr size_t WS_RSTDM = WS_RSTDX + al256((size_t)NTOK * 4);
constexpr size_t WS_ROPEC = WS_RSTDM + al256((size_t)NMROWS * 4);
constexpr size_t WS_ROPES = WS_ROPEC + al256((size_t)NTOK * 32 * 4);
constexpr size_t WS_CQ = WS_ROPES + al256((size_t)NTOK * 32 * 4);
constexpr size_t WS_CKV = WS_CQ + al256((size_t)NTOK * 512 * 2);
constexpr size_t WS_U = WS_CKV + al256((size_t)NTOK * 512 * 2);
constexpr size_t WS_VG = WS_U + al256((size_t)NTOK * 512 * 2);
constexpr size_t WS_QM = WS_VG + al256((size_t)NTOK * 512 * 2);
constexpr size_t WS_KPE = WS_QM + al256((size_t)NTOK * 512 * 2);
constexpr size_t WS_MK = WS_KPE + al256((size_t)NTOK * 64 * 2);
constexpr size_t WS_MV = WS_MK + al256((size_t)NMROWS * 512 * 2);
constexpr size_t WS_PARTQ = WS_MV + al256((size_t)NMROWS * 512 * 2);
constexpr size_t WS_PARTKV = WS_PARTQ + al256((size_t)8 * NTOK * 4);
constexpr size_t WS_PARTVG = WS_PARTKV + al256((size_t)8 * NTOK * 4);
constexpr size_t WS_PARTA = WS_PARTVG + al256((size_t)8 * NTOK * 4);
constexpr size_t WS_PARTB = WS_PARTA + al256((size_t)8 * NTOK * 4);
constexpr size_t WS_PARTM = WS_PARTB + al256((size_t)16 * NTOK * 4);
constexpr size_t WS_PARTF = WS_PARTM + al256((size_t)4 * NTOK * 4);
constexpr size_t WS_QBUF = WS_PARTF + al256((size_t)32 * NTOK * 4);
constexpr size_t WS_KBUF = WS_QBUF + al256((size_t)NTOK * 1536 * 2);
constexpr size_t WS_VBUF = WS_KBUF + al256((size_t)NTOK * 1024 * 2);
constexpr size_t WS_OC = WS_VBUF + al256((size_t)NTOK * 1024 * 2);
constexpr size_t WS_XB1 = WS_OC + al256((size_t)NTOK * 2048 * 2);
constexpr size_t WS_LTOK = WS_XB1 + al256((size_t)NTOK * 2048);
constexpr size_t WS_LRS = WS_LTOK + al256((size_t)NE * LCAP * 4);
constexpr size_t WS_LGATE = WS_LRS + al256((size_t)NE * LCAP * 4);
constexpr size_t WS_SEL = WS_LGATE + al256((size_t)NE * LCAP * 4);
constexpr size_t WS_ACT = WS_SEL + al256((size_t)NTOK * 4 * 4);
constexpr size_t WS_Y = WS_ACT + al256((size_t)PMAX * 2048);
constexpr size_t WS_END = WS_Y + al256((size_t)PMAX * 2048);
constexpr int CW_BAR = 4096;
constexpr int CW_P3DONE = 32768;
constexpr int CW_CNT = 16384;

constexpr int RING_BYTES = 131072;
constexpr int EPI_OFF = 131072;
constexpr int S4_OFF = 139264;
constexpr int BIAS_OFF = 139264;
constexpr int ROW_OFF = 155648;
constexpr int MOE_OFF = 157696;
constexpr int MISC_OFF = 158720;
constexpr int PT_OFF = 158976;
constexpr int LDS_BYTES = 163840;
static_assert(S4_OFF + 8192 <= ROW_OFF && BIAS_OFF + 16384 <= ROW_OFF && ROW_OFF + 2048 <= MOE_OFF && MOE_OFF + 1024 <= MISC_OFF && PT_OFF + 256 <= LDS_BYTES && 8 * 16640 <= BIAS_OFF + 16384, "LDS map");

__device__ __forceinline__ unsigned cvt_pk_bf16(float lo, float hi) { unsigned r; asm volatile("v_cvt_pk_bf16_f32 %0, %1, %2" : "=v"(r) : "v"(lo), "v"(hi)); return r; }
__device__ __forceinline__ u32x4 pack8(f32x4 a, f32x4 b) { u32x4 w; w.x = cvt_pk_bf16(a[0], a[1]); w.y = cvt_pk_bf16(a[2], a[3]); w.z = cvt_pk_bf16(b[0], b[1]); w.w = cvt_pk_bf16(b[2], b[3]); return w; }
__device__ __forceinline__ void store8(bf16* p, f32x4 a, f32x4 b) { *(u32x4*)p = pack8(a, b); }
__device__ __forceinline__ u32x2 pack8_fp8(f32x4 a, f32x4 b) { int lo = __builtin_amdgcn_cvt_pk_fp8_f32(a[0], a[1], 0, false); lo = __builtin_amdgcn_cvt_pk_fp8_f32(a[2], a[3], lo, true);
    int hi = __builtin_amdgcn_cvt_pk_fp8_f32(b[0], b[1], 0, false); hi = __builtin_amdgcn_cvt_pk_fp8_f32(b[2], b[3], hi, true); return (u32x2){(unsigned)lo, (unsigned)hi}; }
__device__ __forceinline__ float dot4(f32x4 a) { return (a[0] * a[0] + a[1] * a[1]) + (a[2] * a[2] + a[3] * a[3]); }
__device__ __forceinline__ float red4(float s) { s += __shfl_xor(s, 16); s += __shfl_xor(s, 32); return s; }
__device__ __forceinline__ float wave_sum(float v) {
#pragma unroll
    for (int o = 1; o < 64; o <<= 1) v += __shfl_xor(v, o);
    return v;
}
__device__ __forceinline__ int fresh_lane() { int l; asm volatile("v_mbcnt_lo_u32_b32 %0, -1, 0\n\tv_mbcnt_hi_u32_b32 %0, -1, %0" : "=v"(l)); return l; }
__device__ __forceinline__ float bf2f(unsigned short b) { return __uint_as_float(((unsigned)b) << 16); }
__device__ __forceinline__ f32x2 gelu_pk(f32x2 v) {
    const f32x2 av = __builtin_elementwise_abs(v), d = av * 0.2316418882f + 1.0f;
    f32x2 t; t.x = __builtin_amdgcn_rcpf(d.x); t.y = __builtin_amdgcn_rcpf(d.y);
    f32x2 q = t * 0.5307027145f + (-0.7265760135f); q = q * t + 0.7107068705f; q = q * t + (-0.142248368f); q = q * t + 0.127414796f; q = q * t;
    const f32x2 s = (v * v) * (-0.72134752044f);
    f32x2 e; e.x = __builtin_amdgcn_exp2f(s.x); e.y = __builtin_amdgcn_exp2f(s.y);
    const f32x2 m = v * (q * e), r = v - m;
    f32x2 o; o.x = v.x < 0.f ? m.x : r.x; o.y = v.y < 0.f ? m.y : r.y; return o;
}
__device__ __forceinline__ f32x4 gelu4(f32x4 v) { f32x2 a = gelu_pk((f32x2){v[0], v[1]}), b = gelu_pk((f32x2){v[2], v[3]}); return (f32x4){a.x, a.y, b.x, b.y}; }

struct Args {
    const float* in[31];
    float* out;
    unsigned char* ws;
    float invf[32];
    int ph_lo, ph_hi;
};

namespace pg8 {
constexpr int BM = 256, BK = 64, HALF = 128, HTB = HALF * BK * 2, STAGE_BYTES = 8 * HTB;
__host__ __device__ __forceinline__ int lds_byte(int r, int cb) { return (r >> 3) * 1024 + (r & 7) * 128 + ((((cb >> 4) ^ ((r >> 1) & 7)) << 4) | (cb & 15)); }
__host__ __device__ __forceinline__ void stage_rc(int b, int& R, int& CB) { const int r = (b >> 10) * 8 + ((b >> 7) & 7); R = r; CB = ((((b >> 4) & 7) ^ ((r >> 1) & 7)) << 4) | (b & 15); }
__host__ __device__ __forceinline__ int perm32(int rho) { const int n = rho >> 4, i = rho & 15; return 8 * (i >> 2) + 4 * n + (i & 3); }

template <class Epi, class Sched, bool GATHER, bool FP8>
__device__ __forceinline__ void gemm_phase(LAS unsigned char* lds, const int nt, const int pitchA, const int kstA, const int pitchB, const int kstB, const Sched& S, const Epi& E) {
    typedef typename Sched::Unit Unit;
    const int tid = threadIdx.x, wid = __builtin_amdgcn_readfirstlane(tid >> 6), lane = tid & 63, wr = wid >> 2, wc = wid & 3, fr = lane & 15, fq = lane >> 4;
    unsigned voffA[2], voffB[2]; int RA[2], CA[2];
#pragma unroll
    for (int i = 0; i < 2; ++i) { int R, C; stage_rc(tid * 16 + i * 8192, R, C); const int Rb = (R & ~31) + perm32(R & 31); RA[i] = R; CA[i] = C;
        voffA[i] = (unsigned)(R * pitchA + C); voffB[i] = (unsigned)(Rb * pitchB + C); }
    const size_t kstepA = (size_t)kstA, kstepB = (size_t)kstB;
    const unsigned hstep = (unsigned)HALF * (unsigned)pitchA, hstepB = (unsigned)HALF * (unsigned)pitchB;
    const unsigned ldsw = (unsigned)wid * 1024u;
    const int aoff0 = lds_byte(wr * 64 + fr, fq * 16), aoff1 = lds_byte(wr * 64 + fr, 64 + fq * 16), boff0 = lds_byte(wc * 32 + fr, fq * 16), boff1 = lds_byte(wc * 32 + fr, 64 + fq * 16);
#define PG8_SA(b, h) (((b) * 2 + (h)) * HTB)
#define PG8_SB(b, h) ((4 + (b) * 2 + (h)) * HTB)
#define PG8_STAGE_B(bufoff, gbase) do { _Pragma("unroll") for (int _i = 0; _i < 2; ++_i) { unsigned _o = voffB[_i]; asm volatile("" : "+v"(_o));     \
        __builtin_amdgcn_global_load_lds((const unsigned*)((const char*)(gbase) + _o), (LAS unsigned*)(lds + (bufoff) + ldsw + _i * 8192), 16, 0, 0); } } while (0)
#define PG8_STAGE_A(bufoff, kptr, h) do { _Pragma("unroll") for (int _i = 0; _i < 2; ++_i) { \
        unsigned _o = GATHER ? vC[h][_i] : (voffA[_i] + (unsigned)(h) * hstep); asm volatile("" : "+v"(_o)); \
        __builtin_amdgcn_global_load_lds((const unsigned*)((const char*)(kptr) + _o), (LAS unsigned*)(lds + (bufoff) + ldsw + _i * 8192), 16, 0, 0); } } while (0)
#define PG8_LDA(dst, b, h) do { _Pragma("unroll") for (int m = 0; m < 4; ++m) _Pragma("unroll") for (int k = 0; k < 2; ++k) dst[m][k] = *(const LAS i32x4*)(lds + PG8_SA(b, h) + (k ? aoff1 : aoff0) + m * 2048); } while (0)
#define PG8_LDB(dst, b, h) do { _Pragma("unroll") for (int n = 0; n < 2; ++n) _Pragma("unroll") for (int k = 0; k < 2; ++k) dst[n][k] = *(const LAS i32x4*)(lds + PG8_SB(b, h) + (k ? boff1 : boff0) + n * 2048); } while (0)
#define PG8_MMA(ai, bj, At, Bt) do { __builtin_amdgcn_s_setprio(1); _Pragma("unroll") for (int m = 0; m < 4; ++m) _Pragma("unroll") for (int n = 0; n < 2; ++n) { \
        if constexpr (FP8) { acc[ai][bj][m][n] = __builtin_amdgcn_mfma_scale_f32_16x16x128_f8f6f4(__builtin_shufflevector(Bt[n][0], Bt[n][1], 0, 1, 2, 3, 4, 5, 6, 7), __builtin_shufflevector(At[m][0], At[m][1], 0, 1, 2, 3, 4, 5, 6, 7), \
                acc[ai][bj][m][n], 0, 0, 0, 0, 0, 0); } \
        else { _Pragma("unroll") for (int k = 0; k < 2; ++k) acc[ai][bj][m][n] = __builtin_amdgcn_mfma_f32_16x16x32_bf16(__builtin_bit_cast(bf16x8, Bt[n][k]), __builtin_bit_cast(bf16x8, At[m][k]), acc[ai][bj][m][n], 0, 0, 0); } } \
        __builtin_amdgcn_s_setprio(0); } while (0)
#define PG8_WAIT_V(n) asm volatile("s_waitcnt vmcnt(" #n ")" ::: "memory")
#define PG8_WAIT_L(n) asm volatile("s_waitcnt lgkmcnt(" #n ")" ::: "memory")
#define PG8_BAR __builtin_amdgcn_s_barrier()
#define PG8_SCHED __builtin_amdgcn_sched_barrier(0)
    Unit cur, nxt; int ui = 0;
    if (!S.next(0, cur)) return;
    f32x4 acc[2][2][4][2];
#pragma unroll
    for (int a = 0; a < 2; ++a)
#pragma unroll
        for (int b = 0; b < 2; ++b)
#pragma unroll
            for (int m = 0; m < 4; ++m)
#pragma unroll
                for (int n = 0; n < 2; ++n) acc[a][b][m][n] = (f32x4){0.f, 0.f, 0.f, 0.f};
    i32x4 At[4][2], B0[2][2], B1[2][2];
    const char* cA = cur.A; const char* cB = cur.B;
    unsigned vC[2][2];
    LAS u32x4* stash = (LAS u32x4*)(lds + EPI_OFF) + tid;
    if constexpr (GATHER) {
#pragma unroll
        for (int h = 0; h < 2; ++h)
#pragma unroll
            for (int i = 0; i < 2; ++i) vC[h][i] = S.row_off(cur, h * 128 + RA[i]) + (unsigned)CA[i];
    } else {
#pragma unroll
        for (int h = 0; h < 2; ++h)
#pragma unroll
            for (int i = 0; i < 2; ++i) vC[h][i] = 0u;
    }
    if constexpr (Epi::BEGIN) E.begin(cur, 0, lds);
    int mseq = 0;
    if constexpr (Epi::META) { E.meta_load(cur, 0, lds); E.bias_load(cur, lds); }
    PG8_STAGE_B(PG8_SB(0, 0), cB); PG8_STAGE_B(PG8_SB(0, 1), cB + hstepB); PG8_STAGE_A(PG8_SA(0, 0), cA, 0); PG8_STAGE_A(PG8_SA(0, 1), cA, 1);
    if (wr == 1) PG8_BAR;
    PG8_WAIT_V(2); PG8_BAR;
    PG8_STAGE_B(PG8_SB(1, 0), cB + kstepB); PG8_STAGE_A(PG8_SA(1, 0), cA + kstepA, 0); PG8_STAGE_B(PG8_SB(1, 1), cB + hstepB + kstepB);
    PG8_WAIT_V(6); PG8_BAR;
    for (;;) {
        const bool has_next = S.next(ui + 1, nxt);
        const char* nA = has_next ? nxt.A : cA; const char* nB = has_next ? nxt.B : cB;
        bool nnew = true;
        if constexpr (Epi::META) { nnew = has_next && nxt.newm; if (nnew) E.meta_load(nxt, (mseq + 1) & 1, lds); }
        if constexpr (GATHER) {
            if (has_next && nnew) { const int t2 = wid * 64 + fresh_lane(); u32x4 vn;
#pragma unroll
                for (int i = 0; i < 2; ++i) { int R, C; stage_rc(t2 * 16 + i * 8192, R, C);
#pragma unroll
                    for (int h = 0; h < 2; ++h) vn[h * 2 + i] = S.row_off(nxt, h * 128 + R) + (unsigned)C; }
                *stash = vn; }
        }
        for (int t = 0; t < nt; t += 2) {
            const bool last = (t == nt - 2);
            if constexpr (Epi::KHOOK) E.khook(acc, t, wr, fr, ui, lds);
            const char* a1 = cA + (size_t)(t + 1) * kstepA;
            const char* a2 = last ? nA : cA + (size_t)(t + 2) * kstepA; const char* b2 = last ? nB : cB + (size_t)(t + 2) * kstepB;
            const char* a3 = a2 + kstepA; const char* b3 = b2 + kstepB;
            PG8_LDB(B0, 0, 0); PG8_LDB(B1, 0, 1); PG8_SCHED; PG8_LDA(At, 0, 0); PG8_STAGE_A(PG8_SA(1, 1), a1, 1);
            if constexpr (GATHER) { if (last && has_next && nnew) { const u32x4 vn = *stash; vC[0][0] = vn[0]; vC[0][1] = vn[1]; vC[1][0] = vn[2]; vC[1][1] = vn[3]; } }
            PG8_WAIT_V(8); PG8_WAIT_L(0); PG8_BAR; PG8_MMA(0, 0, At, B0); PG8_MMA(0, 1, At, B1); PG8_BAR; PG8_SCHED;
            PG8_LDA(At, 0, 1); PG8_STAGE_B(PG8_SB(0, 0), b2); PG8_STAGE_B(PG8_SB(0, 1), b2 + hstepB); PG8_STAGE_A(PG8_SA(0, 0), a2, 0);
            PG8_WAIT_V(8); PG8_WAIT_L(0); PG8_BAR; PG8_MMA(1, 0, At, B0); PG8_MMA(1, 1, At, B1); PG8_BAR; PG8_SCHED;
            PG8_LDB(B0, 1, 0); PG8_LDB(B1, 1, 1); PG8_SCHED; PG8_LDA(At, 1, 0); PG8_STAGE_A(PG8_SA(0, 1), a2, 1);
            PG8_WAIT_V(8); PG8_WAIT_L(0); PG8_BAR; PG8_MMA(0, 0, At, B0); PG8_MMA(0, 1, At, B1); PG8_BAR; PG8_SCHED;
            PG8_LDA(At, 1, 1); PG8_STAGE_B(PG8_SB(1, 0), b3); PG8_STAGE_B(PG8_SB(1, 1), b3 + hstepB); PG8_STAGE_A(PG8_SA(1, 0), a3, 0);
            PG8_WAIT_V(8); PG8_WAIT_L(0); PG8_BAR; PG8_MMA(1, 0, At, B0); PG8_MMA(1, 1, At, B1); PG8_BAR; PG8_SCHED;
        }
        if (wr == 0) PG8_BAR;
        { const int l2 = fresh_lane(); E(acc, cur, wr, wc, l2 & 15, l2 >> 4, Epi::META ? mseq : ui, lds); }
        if (!has_next) break;
#pragma unroll
        for (int a = 0; a < 2; ++a)
#pragma unroll
            for (int b = 0; b < 2; ++b)
#pragma unroll
                for (int m = 0; m < 4; ++m)
#pragma unroll
                    for (int n = 0; n < 2; ++n) acc[a][b][m][n] = (f32x4){0.f, 0.f, 0.f, 0.f};
        if constexpr (Epi::META) { if (nnew) { ++mseq; if (nxt.e != cur.e) { PG8_BAR; E.bias_load(nxt, lds); } } }
        cur = nxt; cA = nA; cB = nB; ++ui;
        if constexpr (Epi::BEGIN) E.begin(cur, ui, lds);
        if (wr == 1) PG8_BAR;
    }
    PG8_WAIT_V(0);
    PG8_BAR;
#undef PG8_SA
#undef PG8_SB
#undef PG8_STAGE_A
#undef PG8_STAGE_B
#undef PG8_LDA
#undef PG8_LDB
#undef PG8_MMA
#undef PG8_WAIT_V
#undef PG8_WAIT_L
#undef PG8_BAR
#undef PG8_SCHED
}
}

typedef f32x4 AccT[2][2][4][2];
#define ROWL(ai, m) (128 * (ai) + 64 * wr + 16 * (m) + fr)
#define COLL(bj) (128 * (bj) + 32 * wc + 8 * fq)

__device__ __forceinline__ void normalize_halves(AccT& acc, LAS unsigned char* lds, int wr, int wc, int fr, int fq, bool apply) {
    LAS float* P = (LAS float*)(lds + EPI_OFF);
    float r[2][4][2];
    if (apply) {
#pragma unroll
        for (int ai = 0; ai < 2; ++ai)
#pragma unroll
            for (int m = 0; m < 4; ++m)
#pragma unroll
                for (int bj = 0; bj < 2; ++bj) { float s = dot4(acc[ai][bj][m][0]) + dot4(acc[ai][bj][m][1]); s = red4(s);
                    if (fq == 0) P[(bj * 256 + ROWL(ai, m)) * 4 + wc] = s; }
        asm volatile("s_waitcnt lgkmcnt(0)" ::: "memory"); __builtin_amdgcn_s_barrier(); asm volatile("" ::: "memory");
#pragma unroll
        for (int ai = 0; ai < 2; ++ai)
#pragma unroll
            for (int m = 0; m < 4; ++m)
#pragma unroll
                for (int bj = 0; bj < 2; ++bj) { const f32x4 p = *(const LAS f32x4*)(P + (bj * 256 + ROWL(ai, m)) * 4);
                    r[ai][m][bj] = rsqrtf(((p[0] + p[1]) + (p[2] + p[3])) * (1.0f / 128.0f) + EPS); }
        asm volatile("s_waitcnt lgkmcnt(0)" ::: "memory");
    } else {
#pragma unroll
        for (int ai = 0; ai < 2; ++ai)
#pragma unroll
            for (int m = 0; m < 4; ++m) { r[ai][m][0] = 1.0f; r[ai][m][1] = 1.0f; }
    }
#pragma unroll
    for (int ai = 0; ai < 2; ++ai)
#pragma unroll
        for (int m = 0; m < 4; ++m)
#pragma unroll
            for (int bj = 0; bj < 2; ++bj) { float f = r[ai][m][bj]; asm volatile("" : "+v"(f)); acc[ai][bj][m][0] *= f; acc[ai][bj][m][1] *= f; }
}
__device__ __forceinline__ void rope_rows(AccT& acc, int row0, int wr, int fr, int fq, const float* RC, const float* RS, bf16* dst, int pitch, int coloff) {
#pragma unroll
    for (int ai = 0; ai < 2; ++ai)
#pragma unroll
        for (int m = 0; m < 4; ++m) {
            const int row = row0 + ROWL(ai, m);
            float s = dot4(acc[ai][0][m][0]) + dot4(acc[ai][0][m][1]) + dot4(acc[ai][1][m][0]) + dot4(acc[ai][1][m][1]); s = red4(s);
            const float r = rsqrtf(s * (1.0f / 64.0f) + EPS);
            const f32x4 c0 = *(const f32x4*)(RC + (size_t)row * 32 + 8 * fq), c1 = *(const f32x4*)(RC + (size_t)row * 32 + 8 * fq + 4);
            const f32x4 s0 = *(const f32x4*)(RS + (size_t)row * 32 + 8 * fq), s1 = *(const f32x4*)(RS + (size_t)row * 32 + 8 * fq + 4);
            const f32x4 a0 = acc[ai][0][m][0] * r, a1 = acc[ai][0][m][1] * r, b0 = acc[ai][1][m][0] * r, b1 = acc[ai][1][m][1] * r;
            bf16* d = dst + (size_t)row * pitch + coloff + 8 * fq;
            store8(d, a0 * c0 - b0 * s0, a1 * c1 - b1 * s1);
            store8(d + 32, a0 * s0 + b0 * c0, a1 * s1 + b1 * c1);
            asm volatile("" ::: "memory");
        }
}

struct UnitG { const char* A; const char* B; int pm, pn, kind; };
struct Sched1 {
    typedef UnitG Unit;
    int G, c; const bf16 *XB, *W1T, *MEMB, *WMKVT;
    __device__ __forceinline__ bool next(int i, Unit& u) const {
        const int L = i * G + c; if (L >= 720) return false;
        if (L < 704) { const int g8 = L / 88, r = L - g8 * 88; u.pm = g8 * 8 + (r & 7); u.pn = r >> 3; u.kind = 0;
            u.A = (const char*)(XB + (size_t)u.pm * 256 * 2048); u.B = (const char*)(W1T + (size_t)u.pn * 256 * 2048); }
        else { const int r = L - 704; u.pm = r >> 2; u.pn = r & 3; u.kind = 1;
            u.A = (const char*)(MEMB + (size_t)u.pm * 256 * 2048); u.B = (const char*)(WMKVT + (size_t)u.pn * 256 * 2048); }
        return true;
    }
};
struct Epi1 {
    static constexpr bool KHOOK = false, BEGIN = false, META = false;
    const float *rstdx, *rstdm, *RC, *RS; bf16 *CQ, *CKV, *U, *VG, *QM, *KPE, *MK, *MV; float *PARTQ, *PARTKV, *PARTVG;
    __device__ __forceinline__ void operator()(AccT& acc, const UnitG& u, int wr, int wc, int fr, int fq, int, LAS unsigned char* lds) const {
        const int row0 = u.pm * 256, pn = u.pn; const float* rsp = (u.kind ? rstdm : rstdx) + row0;
#pragma unroll
        for (int ai = 0; ai < 2; ++ai)
#pragma unroll
            for (int m = 0; m < 4; ++m) { const float rs = rsp[ROWL(ai, m)];
#pragma unroll
                for (int bj = 0; bj < 2; ++bj) { acc[ai][bj][m][0] *= rs; acc[ai][bj][m][1] *= rs; } }
        asm volatile("" ::: "memory");
        normalize_halves(acc, lds, wr, wc, fr, fq, (u.kind == 1 && pn < 2) || (u.kind == 0 && pn >= 8 && pn < 10));
        if (u.kind == 1 || (pn >= 8 && pn < 10)) {
            bf16* dst = u.kind == 1 ? (pn < 2 ? MK + pn * 256 : MV + (pn - 2) * 256) : QM + (pn - 8) * 256;
            dst += 32 * wc + 8 * fq;
#pragma unroll
            for (int ai = 0; ai < 2; ++ai)
#pragma unroll
                for (int m = 0; m < 4; ++m) {
#pragma unroll
                    for (int bj = 0; bj < 2; ++bj) store8(dst + (size_t)(row0 + ROWL(ai, m)) * 512 + 128 * bj, acc[ai][bj][m][0], acc[ai][bj][m][1]);
                    asm volatile("" ::: "memory"); }
            return;
        }
        if (pn < 4) {
            bf16* dst = (pn < 2 ? CQ : CKV) + (pn & 1) * 256 + 32 * wc + 8 * fq; float* part = (pn < 2 ? PARTQ : PARTKV) + (size_t)((pn & 1) * 4 + wc) * NTOK;
#pragma unroll
            for (int ai = 0; ai < 2; ++ai)
#pragma unroll
                for (int m = 0; m < 4; ++m) { const int row = row0 + ROWL(ai, m); float ss = 0.f;
#pragma unroll
                    for (int bj = 0; bj < 2; ++bj) { ss += dot4(acc[ai][bj][m][0]) + dot4(acc[ai][bj][m][1]); store8(dst + (size_t)row * 512 + 128 * bj, acc[ai][bj][m][0], acc[ai][bj][m][1]); }
                    ss = red4(ss); if (fq == 0) part[row] = ss;
                    asm volatile("" ::: "memory"); }
        } else if (pn < 8) {
            bf16* dst = (pn < 6 ? U : VG) + (pn & 1) * 256 + 32 * wc + 8 * fq; float* part = PARTVG + (size_t)((pn & 1) * 4 + wc) * NTOK;
#pragma unroll
            for (int ai = 0; ai < 2; ++ai)
#pragma unroll
                for (int m = 0; m < 4; ++m) { const int row = row0 + ROWL(ai, m); float ss = 0.f;
#pragma unroll
                    for (int bj = 0; bj < 2; ++bj) { const f32x4 g0 = gelu4(acc[ai][bj][m][0]), g1 = gelu4(acc[ai][bj][m][1]); ss += dot4(g0) + dot4(g1); store8(dst + (size_t)row * 512 + 128 * bj, g0, g1); }
                    ss = red4(ss); if (pn >= 6 && fq == 0) part[row] = ss;
                    asm volatile("" ::: "memory"); }
        } else {
            if (wc == 0) rope_rows(acc, row0, wr, fr, fq, RC, RS, KPE, 64, 0);
        }
    }
};

struct Sched2 {
    typedef UnitG Unit;
    int G, c; const bf16 *CQ, *CKV, *WQBT, *WKVBT;
    __device__ __forceinline__ bool next(int i, Unit& u) const {
        const int L = i * G + c; if (L >= 896) return false;
        const int g8 = L / 112, r = L - g8 * 112; u.pm = g8 * 8 + (r & 7); const int pn = r >> 3;
        if (pn < 6) { u.kind = 0; u.pn = pn; u.A = (const char*)(CQ + (size_t)u.pm * 256 * 512); u.B = (const char*)(WQBT + (size_t)pn * 256 * 512); }
        else { u.kind = 1; u.pn = pn - 6; u.A = (const char*)(CKV + (size_t)u.pm * 256 * 512); u.B = (const char*)(WKVBT + (size_t)(pn - 6) * 256 * 512); }
        return true;
    }
};
struct Epi2 {
    static constexpr bool KHOOK = false, BEGIN = true, META = false;
    const float *PARTQ, *PARTKV, *RC, *RS; bf16 *QBUF, *KBUF, *VBUF;
    __device__ __forceinline__ void begin(const UnitG& u, int ui, LAS unsigned char* lds) const {
        if (threadIdx.x < 256) {
            LAS float* S4 = (LAS float*)(lds + S4_OFF) + (ui & 1) * 1024;
            const float* part = (u.kind ? PARTKV : PARTQ) + u.pm * 256 + threadIdx.x; float s = 0.f;
#pragma unroll
            for (int k = 0; k < 8; ++k) s += part[(size_t)k * NTOK];
            S4[threadIdx.x * 4] = rsqrtf(s * (1.0f / 512.0f) + EPS);
        }
    }
    __device__ __forceinline__ void operator()(AccT& acc, const UnitG& u, int wr, int wc, int fr, int fq, int ui, LAS unsigned char* lds) const {
        const LAS float* S4 = (const LAS float*)(lds + S4_OFF) + (ui & 1) * 1024;
        const int row0 = u.pm * 256, pn = u.pn;
#pragma unroll
        for (int ai = 0; ai < 2; ++ai)
#pragma unroll
            for (int m = 0; m < 4; ++m) { const float rs = S4[ROWL(ai, m) * 4];
#pragma unroll
                for (int bj = 0; bj < 2; ++bj) { acc[ai][bj][m][0] *= rs; acc[ai][bj][m][1] *= rs; } }
        normalize_halves(acc, lds, wr, wc, fr, fq, pn < 4);
        if (u.kind == 0 && pn >= 4) {
            const int h = 4 * (pn - 4) + wc;
            rope_rows(acc, row0, wr, fr, fq, RC, RS, QBUF, 1536, h * 192 + 128);
            return;
        }
        bf16* dst; int pitch, hs;
        if (u.kind == 0) { dst = QBUF + (2 * pn) * 192; pitch = 1536; hs = 192; }
        else if (pn < 4) { dst = KBUF + (2 * pn) * 128; pitch = 1024; hs = 128; }
        else { dst = VBUF + (2 * (pn - 4)) * 128; pitch = 1024; hs = 128; }
        dst += 32 * wc + 8 * fq;
#pragma unroll
        for (int ai = 0; ai < 2; ++ai)
#pragma unroll
            for (int m = 0; m < 4; ++m) {
#pragma unroll
                for (int bj = 0; bj < 2; ++bj) store8(dst + (size_t)(row0 + ROWL(ai, m)) * pitch + bj * hs, acc[ai][bj][m][0], acc[ai][bj][m][1]);
                asm volatile("" ::: "memory"); }
    }
};

struct Sched4 {
    typedef UnitG Unit;
    int G, c, cnt; const bf16 *OC, *WOT;
    __device__ __forceinline__ bool next(int i, Unit& u) const {
        const int L = i * G + c; if (i >= cnt || L >= 512) return false;
        const int g8 = L >> 6, r = L & 63; u.pm = g8 * 8 + (r & 7); u.pn = r >> 3; u.kind = 0;
        u.A = (const char*)(OC + (size_t)u.pm * 256 * 2048); u.B = (const char*)(WOT + (size_t)u.pn * 256 * 2048); return true;
    }
};
struct Epi4 {
    static constexpr bool KHOOK = true, BEGIN = true, META = false;
    const float *PARTA, *PARTB, *PARTM, *fgain; bf16* xb; float* PARTF; unsigned char* XQ1;
    __device__ __forceinline__ void begin(const UnitG& u, int ui, LAS unsigned char* lds) const {
        if (threadIdx.x < 256) {
            LAS float* S4 = (LAS float*)(lds + S4_OFF) + (ui & 1) * 1024;
            const int row = u.pm * 256 + threadIdx.x; float sa = 0.f, sb = 0.f, sc = 0.f;
#pragma unroll
            for (int k = 0; k < 8; ++k) sa += PARTA[(size_t)k * NTOK + row];
#pragma unroll
            for (int k = 0; k < 16; ++k) sb += PARTB[(size_t)k * NTOK + row];
#pragma unroll
            for (int k = 0; k < 4; ++k) sc += PARTM[(size_t)k * NTOK + row];
            const float rA = rsqrtf(sa * (1.0f / 1024.0f) + EPS), rB = rsqrtf(sb * (1.0f / 512.0f) + EPS), rC = rsqrtf(sc * (1.0f / 512.0f) + EPS);
            *(LAS f32x4*)(S4 + threadIdx.x * 4) = (f32x4){rA / rB, rB / rC, rC, 0.f};
        }
    }
    __device__ __forceinline__ void khook(AccT& acc, int t, int wr, int fr, int ui, LAS unsigned char* lds) const {
        if (t == 16 || t == 24) {
            const LAS float* S4 = (const LAS float*)(lds + S4_OFF) + (ui & 1) * 1024 + (t == 16 ? 0 : 1);
#pragma unroll
            for (int ai = 0; ai < 2; ++ai)
#pragma unroll
                for (int m = 0; m < 4; ++m) { const float f = S4[ROWL(ai, m) * 4];
#pragma unroll
                    for (int bj = 0; bj < 2; ++bj) { acc[ai][bj][m][0] *= f; acc[ai][bj][m][1] *= f; } }
        }
    }
    __device__ __forceinline__ void operator()(AccT& acc, const UnitG& u, int wr, int wc, int fr, int fq, int ui, LAS unsigned char* lds) const {
        const LAS float* S4 = (const LAS float*)(lds + S4_OFF) + (ui & 1) * 1024;
        const int row0 = u.pm * 256, col0 = u.pn * 256; float* part = PARTF + (size_t)(u.pn * 4 + wc) * NTOK;
        u32x4 xw[2][4][2];
#define EPI4_LD(ai, m) do { _Pragma("unroll") for (int bj = 0; bj < 2; ++bj) xw[ai][m][bj] = *(const u32x4*)(xb + (size_t)(row0 + ROWL(ai, m)) * 2048 + col0 + COLL(bj)); } while (0)
#define EPI4_ROW(ai, m) do { const int row = row0 + ROWL(ai, m); const float rC = S4[ROWL(ai, m) * 4 + 2]; float ss = 0.f; \
        _Pragma("unroll") for (int bj = 0; bj < 2; ++bj) { const size_t o = (size_t)row * 2048 + col0 + COLL(bj); const u32x4 w = xw[ai][m][bj]; \
            const f32x4 x0 = {__uint_as_float(w[0] << 16), __uint_as_float(w[0] & 0xffff0000u), __uint_as_float(w[1] << 16), __uint_as_float(w[1] & 0xffff0000u)}; \
            const f32x4 x1 = {__uint_as_float(w[2] << 16), __uint_as_float(w[2] & 0xffff0000u), __uint_as_float(w[3] << 16), __uint_as_float(w[3] & 0xffff0000u)}; \
            const f32x4 o0 = x0 + acc[ai][bj][m][0] * rC, o1 = x1 + acc[ai][bj][m][1] * rC; \
            *(u32x4*)(xb + o) = (u32x4){cvt_pk_bf16(o0[0], o0[1]), cvt_pk_bf16(o0[2], o0[3]), cvt_pk_bf16(o1[0], o1[1]), cvt_pk_bf16(o1[2], o1[3])}; \
            *(u32x2*)(XQ1 + o) = pack8_fp8(o0 * fg[bj][0], o1 * fg[bj][1]); ss += dot4(o0) + dot4(o1); } \
        ss = red4(ss); if (fq == 0) part[row] = ss; asm volatile("" ::: "memory"); } while (0)
        EPI4_LD(0, 0); EPI4_LD(0, 1); EPI4_LD(0, 2); EPI4_LD(0, 3); EPI4_LD(1, 0); EPI4_LD(1, 1);
        f32x4 fg[2][2];
#pragma unroll
        for (int bj = 0; bj < 2; ++bj) { fg[bj][0] = *(const f32x4*)(fgain + col0 + COLL(bj)); fg[bj][1] = *(const f32x4*)(fgain + col0 + COLL(bj) + 4); }
        asm volatile("" ::: "memory");
        EPI4_ROW(0, 0); EPI4_LD(1, 2); EPI4_ROW(0, 1); EPI4_LD(1, 3); EPI4_ROW(0, 2); EPI4_ROW(0, 3);
        EPI4_ROW(1, 0); EPI4_ROW(1, 1); EPI4_ROW(1, 2); EPI4_ROW(1, 3);
#undef EPI4_LD
#undef EPI4_ROW
    }
};

struct UnitM { const char* A; const char* B; int pn, e, mtl, cnt, pstart; bool newm; };
template <bool UP> struct SchedM {
    typedef UnitM Unit;
    int G, c; const LAS int* T;
    const unsigned char *Amat, *Wt; const int* LTOK;
    static constexpr int NPN = UP ? 16 : 8;
    __device__ __forceinline__ void where(int i, int& mt, int& pn) const {
        if (G == 256) { if (i < NPN) { mt = 32 * (c & 7) + (c >> 3); pn = i; } else { const int L = c + 256 * (i - NPN); mt = 256 + L / NPN; pn = L % NPN; } }
        else { const int L = i * G + c; mt = L / NPN; pn = L - mt * NPN; }
    }
    __device__ __forceinline__ bool next(int i, Unit& u) const {
        int mt, pnn; where(i, mt, pnn);
        if (mt >= __builtin_amdgcn_readfirstlane(T[32])) return false;
        int mtp = -1, pnp; if (i > 0) where(i - 1, mtp, pnp); (void)pnp;
        const int lane = fresh_lane();
        const unsigned long long bal = __ballot(lane < 32 && mt >= T[(lane & 31) + 1]);
        const int e = __builtin_popcountll(bal);
        u.pn = pnn; u.e = e; u.newm = (mt != mtp);
        u.mtl = mt - __builtin_amdgcn_readfirstlane(T[e]); u.cnt = __builtin_amdgcn_readfirstlane(T[128 + e]); u.pstart = __builtin_amdgcn_readfirstlane(T[64 + e]);
        u.A = (const char*)Amat;
        u.B = (const char*)(Wt + ((size_t)e * NPN + (size_t)u.pn) * 524288);
        return true;
    }
    __device__ __forceinline__ unsigned row_off(const Unit& u, int rl) const {
        const int slot = u.mtl * 256 + rl;
        if (UP) { const int tok = slot < u.cnt ? LTOK[u.e * LCAP + slot] : 0; return (unsigned)tok * 2048u; }
        else return (unsigned)(((u.pstart >> 8) + u.mtl) * 16 * 256 + rl) * 128u;
    }
};
struct Epi6 {
    static constexpr bool KHOOK = false, BEGIN = false, META = true;
    const float *LRS, *BGU; unsigned char* ACT;
    __device__ __forceinline__ void meta_load(const UnitM& u, int par, LAS unsigned char* lds) const {
        if (threadIdx.x < 256) { const int slot = u.mtl * 256 + threadIdx.x;
            ((LAS float*)(lds + ROW_OFF))[par * 256 + threadIdx.x] = slot < u.cnt ? LRS[u.e * LCAP + slot] * 0.03125f : 0.f; }
    }
    __device__ __forceinline__ void bias_load(const UnitM& u, LAS unsigned char* lds) const {
        const f32x4* src = (const f32x4*)(BGU + (size_t)u.e * 4096) + threadIdx.x; LAS f32x4* dst = (LAS f32x4*)(lds + BIAS_OFF) + threadIdx.x;
        dst[0] = src[0]; dst[512] = src[512];
    }
    __device__ __forceinline__ void operator()(AccT& acc, const UnitM& u, int wr, int wc, int fr, int fq, int mseq, LAS unsigned char* lds) const {
        const int colg = u.pn * 128 + 32 * wc + 8 * fq; const LAS float* bg = (const LAS float*)(lds + BIAS_OFF) + colg; const LAS float* rowf = (const LAS float*)(lds + ROW_OFF) + (mseq & 1) * 256;
        const f32x4 bg0 = *(const LAS f32x4*)bg, bg1 = *(const LAS f32x4*)(bg + 4), bu0 = *(const LAS f32x4*)(bg + 2048), bu1 = *(const LAS f32x4*)(bg + 2052);
#pragma unroll
        for (int ai = 0; ai < 2; ++ai)
#pragma unroll
            for (int m = 0; m < 4; ++m) { const int slot = u.mtl * 256 + ROWL(ai, m); const float rs = rowf[ROWL(ai, m)];
                f32x4 g[2] = {acc[ai][0][m][0] * rs + bg0, acc[ai][0][m][1] * rs + bg1}, up[2] = {acc[ai][1][m][0] * rs + bu0, acc[ai][1][m][1] * rs + bu1}, a[2];
#pragma unroll
                for (int n = 0; n < 2; ++n)
#pragma unroll
                    for (int j = 0; j < 4; ++j) { const float gg = fminf(g[n][j], 7.0f), uu = fminf(fmaxf(up[n][j], -7.0f), 7.0f);
                        const float sg = __builtin_amdgcn_rcpf(1.0f + __builtin_amdgcn_exp2f(gg * (-1.702f * 1.4426950408889634f)));
                        a[n][j] = (uu + 1.0f) * (gg * sg); }
                *(u32x2*)(ACT + ((size_t)(((u.pstart >> 8) + u.mtl) * 16 + u.pn) * 256 + ROWL(ai, m)) * 128 + 32 * wc + 8 * fq) = pack8_fp8(a[0], a[1]);
                asm volatile("" ::: "memory"); }
    }
};
struct Epi7 {
    static constexpr bool KHOOK = false, BEGIN = false, META = true;
    const float *LGATE, *BD; unsigned char* Y;
    __device__ __forceinline__ void meta_load(const UnitM& u, int par, LAS unsigned char* lds) const {
        if (threadIdx.x < 256) { const int slot = u.mtl * 256 + threadIdx.x;
            ((LAS float*)(lds + ROW_OFF))[par * 256 + threadIdx.x] = slot < u.cnt ? LGATE[u.e * LCAP + slot] * 16.0f : 0.f; }
    }
    __device__ __forceinline__ void bias_load(const UnitM& u, LAS unsigned char* lds) const {
        ((LAS f32x4*)(lds + BIAS_OFF))[threadIdx.x] = ((const f32x4*)(BD + (size_t)u.e * 2048))[threadIdx.x];
    }
    __device__ __forceinline__ void operator()(AccT& acc, const UnitM& u, int wr, int wc, int fr, int fq, int mseq, LAS unsigned char* lds) const {
        const int col = u.pn * 256 + 32 * wc + 8 * fq; const LAS float* bp = (const LAS float*)(lds + BIAS_OFF) + col; const LAS float* rowf = (const LAS float*)(lds + ROW_OFF) + (mseq & 1) * 256;
        const f32x4 b00 = *(const LAS f32x4*)bp, b01 = *(const LAS f32x4*)(bp + 4), b10 = *(const LAS f32x4*)(bp + 128), b11 = *(const LAS f32x4*)(bp + 132);
#pragma unroll
        for (int ai = 0; ai < 2; ++ai)
#pragma unroll
            for (int m = 0; m < 4; ++m) { const int slot = u.mtl * 256 + ROWL(ai, m); const float gt = rowf[ROWL(ai, m)];
                unsigned char* yp = Y + ((size_t)u.pstart + slot) * 2048 + col;
                *(u32x2*)yp = pack8_fp8((acc[ai][0][m][0] * 0.03125f + b00) * gt, (acc[ai][0][m][1] * 0.03125f + b01) * gt);
                *(u32x2*)(yp + 128) = pack8_fp8((acc[ai][1][m][0] * 0.03125f + b10) * gt, (acc[ai][1][m][1] * 0.03125f + b11) * gt);
                asm volatile("" ::: "memory"); }
    }
};

namespace att {
constexpr int SHM_V = 64 * 128 * 2;
__device__ __forceinline__ int v_st(int k, int c) { const int kk = (k & ~0xC) | ((k & 4) << 1) | ((k & 8) >> 1); return ((kk >> 3) * 4 + (c >> 5)) * 512 + ((kk & 7) * 32 + (c & 31)) * 2; }
__device__ __forceinline__ int v_rd_base(int lane) { return ((lane & 3) << 3) | (((lane >> 2) & 3) << 6) | (((lane >> 4) & 1) << 5) | (((lane >> 5) & 1) << 8); }
constexpr int v_rd_off(int d0, int ks, int half) { return d0 * 512 + ks * 4096 + half * 2048; }
__device__ __forceinline__ int crow(int r, int hi) { return (r & 3) + 8 * (r >> 2) + 4 * hi; }
__device__ __forceinline__ void mask_tile(f32x16& p0, f32x16& p1, int dq) {
    const float NEG = -__builtin_inff();
#pragma unroll
    for (int r = 0; r < 16; ++r) { const int c = (r & 3) + 8 * (r >> 2);
        if (dq - c < 0) p0[r] = NEG;
        if (dq - c - 32 < 0) p1[r] = NEG; }
}
template <int DK> __device__ __forceinline__ void partialSM(f32x16& p0, f32x16& p1, float& m_reg, float& mn, float& alpha) {
    constexpr float SCALE = DK == 192 ? 0.07216878364870322f : 0.08838834764831845f, THR = 8.f;
    float pmax = p0[0];
#pragma unroll
    for (int r = 1; r < 16; ++r) pmax = fmaxf(pmax, p0[r]);
#pragma unroll
    for (int r = 0; r < 16; ++r) pmax = fmaxf(pmax, p1[r]);
    { auto rr = __builtin_amdgcn_permlane32_swap(__float_as_uint(pmax), __float_as_uint(pmax), false, false);
      pmax = fmaxf(__uint_as_float(rr[0]), __uint_as_float(rr[1])); }
    constexpr float C2 = 1.4426950408889634f * SCALE;
    if (__builtin_expect(__all((pmax - m_reg) * SCALE <= THR), 1)) { mn = m_reg; alpha = 1.f; }
    else { mn = fmaxf(m_reg, pmax); alpha = __builtin_amdgcn_exp2f((m_reg - mn) * C2); m_reg = mn; }
    const float mnL = -mn * C2;
#pragma unroll
    for (int r = 0; r < 16; ++r) p0[r] = fmaf(p0[r], C2, mnL);
#pragma unroll
    for (int r = 0; r < 16; ++r) p1[r] = fmaf(p1[r], C2, mnL);
#pragma unroll
    for (int r = 0; r < 16; ++r) p0[r] = __builtin_amdgcn_exp2f(p0[r]);
}
__device__ __forceinline__ void finishSM(f32x16& p0, f32x16& p1, float alpha, float& l_reg, bf16x8& pa0, bf16x8& pa1, bf16x8& pa2, bf16x8& pa3) {
#pragma unroll
    for (int r = 0; r < 16; ++r) p1[r] = __builtin_amdgcn_exp2f(p1[r]);
    float ps = 0;
#pragma unroll
    for (int r = 0; r < 16; ++r) ps += p0[r];
#pragma unroll
    for (int r = 0; r < 16; ++r) ps += p1[r];
    { auto rr = __builtin_amdgcn_permlane32_swap(__float_as_uint(ps), __float_as_uint(ps), false, false);
      ps = __uint_as_float(rr[0]) + __uint_as_float(rr[1]); }
    l_reg = l_reg * alpha + ps;
#define PK4(P, B_, OUT) do { unsigned a0 = cvt_pk_bf16(P[B_+0], P[B_+1]), a1 = cvt_pk_bf16(P[B_+2], P[B_+3]);                          \
        unsigned b0 = cvt_pk_bf16(P[B_+4], P[B_+5]), b1 = cvt_pk_bf16(P[B_+6], P[B_+7]);                                             \
        auto r0 = __builtin_amdgcn_permlane32_swap(a0, b0, false, false); auto r1 = __builtin_amdgcn_permlane32_swap(a1, b1, false, false); \
        u32x4 w = {r0[0], r1[0], r0[1], r1[1]}; OUT = __builtin_bit_cast(bf16x8, w); } while (0)
    PK4(p0, 0, pa0); PK4(p0, 8, pa1); PK4(p1, 0, pa2); PK4(p1, 8, pa3);
#undef PK4
}
template <int DK, int KB>
__device__ __forceinline__ void qkt(f32x16& p0, f32x16& p1, const LAS unsigned char* K_lds, int r32, int hi, const bf16x8* qr) {
    constexpr int KROW = DK * 2, SHM_K = 64 * KROW;
    p0 = f32x16{}; p1 = f32x16{};
    const LAS unsigned char* kb[4];
#pragma unroll
    for (int dd = 0; dd < 4; ++dd) kb[dd] = K_lds + KB * SHM_K + r32 * KROW + (((dd * 16 + hi * 8) * 2) ^ ((r32 & 7) << 4));
#pragma unroll
    for (int d0 = 0; d0 < DK / 16; ++d0) { const LAS unsigned char* a = kb[d0 & 3] + (d0 >> 2) * 128;
        const bf16x8 b0 = *(const LAS bf16x8*)a;
        const bf16x8 b1 = *(const LAS bf16x8*)(a + 32 * KROW);
        p0 = __builtin_amdgcn_mfma_f32_32x32x16_bf16(b0, qr[d0], p0, 0, 0, 0);
        p1 = __builtin_amdgcn_mfma_f32_32x32x16_bf16(b1, qr[d0], p1, 0, 0, 0); }
}
template <int VB>
__device__ __forceinline__ void pv_tile(f32x16* o, int vb0, bf16x8 pa0, bf16x8 pa1, bf16x8 pa2, bf16x8 pa3) {
#define TRRD(dst, off) asm volatile("ds_read_b64_tr_b16 %0, %1 offset:%2" : "=&v"(dst) : "v"(vb0), "i"(off) : "memory")
#define PV_D0(d0) do { s16x4 l0, l1, l2, l3, h0, h1, h2, h3; constexpr int b_ = VB * SHM_V + v_rd_off(d0, 0, 0); \
        TRRD(l0, b_); TRRD(h0, b_ + 2048); TRRD(l1, b_ + 4096); TRRD(h1, b_ + 6144); TRRD(l2, b_ + 8192); TRRD(h2, b_ + 10240); TRRD(l3, b_ + 12288); TRRD(h3, b_ + 14336); \
        asm volatile("s_waitcnt lgkmcnt(0)" ::: "memory"); __builtin_amdgcn_sched_barrier(0);   \
        o[d0] = __builtin_amdgcn_mfma_f32_32x32x16_bf16(pa0, (bf16x8){l0[0], l0[1], l0[2], l0[3], h0[0], h0[1], h0[2], h0[3]}, o[d0], 0, 0, 0);   \
        o[d0] = __builtin_amdgcn_mfma_f32_32x32x16_bf16(pa1, (bf16x8){l1[0], l1[1], l1[2], l1[3], h1[0], h1[1], h1[2], h1[3]}, o[d0], 0, 0, 0);   \
        o[d0] = __builtin_amdgcn_mfma_f32_32x32x16_bf16(pa2, (bf16x8){l2[0], l2[1], l2[2], l2[3], h2[0], h2[1], h2[2], h2[3]}, o[d0], 0, 0, 0);   \
        o[d0] = __builtin_amdgcn_mfma_f32_32x32x16_bf16(pa3, (bf16x8){l3[0], l3[1], l3[2], l3[3], h3[0], h3[1], h3[2], h3[3]}, o[d0], 0, 0, 0); } while (0)
    PV_D0(0); PV_D0(1); PV_D0(2); PV_D0(3);
#undef PV_D0
#undef TRRD
}
template <int DK, bool CAUSAL>
__device__ __forceinline__ void attn_block(LAS unsigned char* lds, const bf16* Q, int qp, const bf16* Kn, int kp, const bf16* Kr, const bf16* V, int vp,
                                           bf16* O, int op, float* part, int P0, int NT) {
    constexpr int KROW = DK * 2, SHM_K = 64 * KROW, ND = DK / 16, NKP = SHM_K / 8192;
    const int tid = threadIdx.x, wid = __builtin_amdgcn_readfirstlane(tid >> 6), lane = tid & 63, r32 = lane & 31, hi = lane >> 5;
    LAS unsigned char* V_lds = lds; LAS unsigned char* K_lds = lds + 2 * SHM_V;
    LAS float* ws = (LAS float*)(lds + 2 * SHM_V + 2 * SHM_K) + wid * 64; LAS float* li_l = ws; LAS float* al_l = ws + 32;
    bf16x8 qr[ND];
#pragma unroll
    for (int d0 = 0; d0 < ND; ++d0) qr[d0] = *(const bf16x8*)(Q + (size_t)(wid * 32 + r32) * qp + d0 * 16 + hi * 8);
    unsigned koff[NKP], voff[2]; bool krope[NKP];
#pragma unroll
    for (int i = 0; i < NKP; ++i) { const int p = (wid * NKP + i) * 1024 + lane * 16, row = p / KROW, cpos = p - row * KROW, x = (row & 7) << 4;
        krope[i] = (DK == 192) && cpos >= 256;
        koff[i] = krope[i] ? (unsigned)(row * 128 + ((cpos - 256) ^ x)) : (unsigned)(row * kp * 2 + (cpos ^ x)); }
#pragma unroll
    for (int i = 0; i < 2; ++i) { const int p = (wid * 2 + i) * 1024 + lane * 16, sub = p >> 9, kk = (sub >> 2) * 8 + ((p & 511) >> 6), cc = (p & 63) >> 1;
        const int k = (kk & ~0xC) | ((kk & 4) << 1) | ((kk & 8) >> 1), c = (sub & 3) * 32 + cc;
        voff[i] = (unsigned)(k * vp * 2 + c * 2); }
    const int vb0 = (int)(unsigned)(uintptr_t)V_lds + v_rd_base(lane);
    const int qlo = P0 + wid * 32, qm = qlo + r32 - 4 * hi;
    float m_reg = -1e30f, l_reg = 0.f; f32x16 o[4] = {};
    f32x16 p0, p1; float mn, alpha; bf16x8 pa0, pa1, pa2, pa3;
#define AT_DMA(k0, bf) do { \
        _Pragma("unroll") for (int i_ = 0; i_ < NKP; ++i_) { const char* s_ = krope[i_] ? (const char*)Kr + (size_t)(k0) * 128 + koff[i_] : (const char*)Kn + (size_t)(k0) * kp * 2 + koff[i_]; \
            __builtin_amdgcn_global_load_lds((const unsigned*)s_, (LAS unsigned*)(K_lds + (bf) * SHM_K + (wid * NKP + i_) * 1024), 16, 0, 0); } \
        _Pragma("unroll") for (int i_ = 0; i_ < 2; ++i_) { const char* s_ = (const char*)V + (size_t)(k0) * vp * 2 + voff[i_]; \
            __builtin_amdgcn_global_load_lds((const unsigned*)s_, (LAS unsigned*)(V_lds + (bf) * SHM_V + (wid * 2 + i_) * 1024), 16, 0, 0); } } while (0)
#define AT_RESC(a) do { if (__any((a) < 1.f)) { if (hi == 0) al_l[r32] = (a); asm volatile("s_waitcnt lgkmcnt(0)" ::: "memory"); \
        _Pragma("unroll") for (int d_ = 0; d_ < 4; ++d_) _Pragma("unroll") for (int r = 0; r < 16; ++r) o[d_][r] *= al_l[crow(r, hi)]; } } while (0)
#define AT_STEP(t, B) do { asm volatile("s_waitcnt vmcnt(0)" ::: "memory"); __syncthreads(); \
        if ((t) + 1 < NT) AT_DMA(((t) + 1) * 64, 1 - (B)); \
        qkt<DK, B>(p0, p1, K_lds, r32, hi, qr); \
        if (CAUSAL) { const int kb_ = (t) * 64; if (kb_ + 63 > qlo) mask_tile(p0, p1, qm - kb_); } \
        partialSM<DK>(p0, p1, m_reg, mn, alpha); AT_RESC(alpha); finishSM(p0, p1, alpha, l_reg, pa0, pa1, pa2, pa3); __builtin_amdgcn_sched_barrier(0); \
        pv_tile<B>(o, vb0, pa0, pa1, pa2, pa3); } while (0)
    AT_DMA(0, 0);
    for (int t = 0; t < NT; t += 2) { AT_STEP(t, 0); AT_STEP(t + 1, 1); }
    if (hi == 0) li_l[r32] = l_reg; asm volatile("s_waitcnt lgkmcnt(0)" ::: "memory");
    bf16* Ow = O + (size_t)(wid * 32) * op; float* pw = part + wid * 32;
#pragma unroll
    for (int r = 0; r < 16; ++r) { const int orow = crow(r, hi); const float rli = __builtin_amdgcn_rcpf(li_l[orow]); float sq = 0.f;
#pragma unroll
        for (int d0 = 0; d0 < 4; ++d0) { const float v = o[d0][r] * rli; sq += v * v; const float vn = __shfl_xor(v, 1);
            if ((r32 & 1) == 0) *(unsigned*)(Ow + (size_t)orow * op + d0 * 32 + r32) = cvt_pk_bf16(v, vn); }
        sq += __shfl_xor(sq, 1); sq += __shfl_xor(sq, 2); sq += __shfl_xor(sq, 4); sq += __shfl_xor(sq, 8); sq += __shfl_xor(sq, 16);
        if (r32 == 0) pw[orow] = sq; }
    asm volatile("s_waitcnt vmcnt(0)" ::: "memory"); __syncthreads();
#undef AT_DMA
#undef AT_RESC
#undef AT_STEP
}
}

#define XB_TMO      128
#define XB_XCNT(j)  (256  + 64 * (j))
#define XB_XSUB(j)  (1280 + 64 * (j))
#define XB_XGEN(j)  (2304 + 64 * (j))
#define XB_TOP      3328
#define XB_TOPGEN   3392
#define XCD_BAR_WORDS 3456
#define XB_SPIN_CAP (1u << 18)
__device__ __forceinline__ unsigned xb_ld(unsigned* p)              { return __hip_atomic_load(p, __ATOMIC_RELAXED, __HIP_MEMORY_SCOPE_AGENT); }
__device__ __forceinline__ unsigned xb_add(unsigned* p, unsigned v) { return __hip_atomic_fetch_add(p, v, __ATOMIC_RELAXED, __HIP_MEMORY_SCOPE_AGENT); }
__device__ __forceinline__ unsigned xb_xcc_id() { return (unsigned)__builtin_amdgcn_s_getreg((3 << 11) | 20) & 0xFu; }
#define XB_SPIN(cond, bar) do { unsigned _sp = 0; while (cond) { __builtin_amdgcn_s_sleep(1); \
    if ((++_sp & 255u) == 0u) { if (xb_ld(&(bar)[XB_TMO])) break; if (_sp > XB_SPIN_CAP) { atomicAdd(&(bar)[XB_TMO], 1u); break; } } } } while (0)
struct XcdBarrier { unsigned* bar; unsigned x; volatile LAS unsigned* st; unsigned total; };
__device__ __forceinline__ XcdBarrier xcd_barrier_post(unsigned* bar, volatile LAS unsigned* st, unsigned total) {
    XcdBarrier b; b.bar = bar; b.x = xb_xcc_id(); b.st = st; b.total = total;
    if (threadIdx.x == 0) (void)xb_add(&bar[XB_XCNT(b.x)], 1u);
    return b;
}
__device__ __forceinline__ void xcd_barrier_complete(unsigned* bar, unsigned x, unsigned& nloc, unsigned& nx, const unsigned G) {
    unsigned sum, cnt, mine, sp = 0u;
    for (;;) {
        sum = 0u; cnt = 0u; mine = 0u;
#pragma unroll
        for (unsigned j = 0; j < 16; ++j) { const unsigned c = xb_ld(&bar[XB_XCNT(j)]); sum += c; cnt += (c > 0u) ? 1u : 0u; mine = (j == x) ? c : mine; }
        if (sum == G) break;
        __builtin_amdgcn_s_sleep(1);
        if ((++sp & 255u) == 0u) { if (xb_ld(&bar[XB_TMO])) break; if (sp > XB_SPIN_CAP) { atomicAdd(&bar[XB_TMO], 1u); break; } }
    }
    nloc = mine > 0u ? mine : 1u; nx = cnt > 0u ? cnt : 1u;
}
__device__ __forceinline__ void xcd_barrier(const XcdBarrier& b) {
    asm volatile("s_waitcnt vmcnt(0)" ::: "memory");
    __syncthreads();
    if (threadIdx.x == 0) {
        unsigned* bar = b.bar;
        __builtin_amdgcn_s_waitcnt(0);
        unsigned nloc = b.st[0], nx = b.st[1];
        if (nloc == 0u) { xcd_barrier_complete(bar, b.x, nloc, nx, b.total); b.st[0] = nloc; b.st[1] = nx; }
        const unsigned old = xb_add(&bar[XB_XSUB(b.x)], 1u);
        const unsigned gen = old / nloc;
        if (old + 1u == (gen + 1u) * nloc) {
            __builtin_amdgcn_fence(__ATOMIC_RELEASE, "agent");
            asm volatile("s_waitcnt vmcnt(0)" ::: "memory");
            const unsigned og = xb_add(&bar[XB_TOP], 1u);
            const unsigned tg = og / nx;
            if (og + 1u == (tg + 1u) * nx) xb_add(&bar[XB_TOPGEN], 1u);
            else XB_SPIN(xb_ld(&bar[XB_TOPGEN]) == tg, bar);
            __builtin_amdgcn_fence(__ATOMIC_ACQUIRE, "agent");
            xb_add(&bar[XB_XGEN(b.x)], 1u);
            asm volatile("s_waitcnt vmcnt(0)" ::: "memory");
        } else {
            XB_SPIN(xb_ld(&bar[XB_XGEN(b.x)]) == gen, bar);
            __builtin_amdgcn_fence(__ATOMIC_ACQUIRE, "agent");
            asm volatile("s_waitcnt vmcnt(0)" ::: "memory");
        }
    }
    __syncthreads();
}

struct InP { const LAS unsigned long long* T;
    __device__ __forceinline__ const float* operator[](int k) const { const unsigned long long v = T[k];
        const unsigned lo = __builtin_amdgcn_readfirstlane((unsigned)v), hi = __builtin_amdgcn_readfirstlane((unsigned)(v >> 32));
        return (const float*)(GAS const float*)(((unsigned long long)hi << 32) | lo); } };
__device__ __forceinline__ float tr_kgain(const InP& a, int mode, int k) {
    switch (mode) {
        case 0: return a[3][k];
        case 1: return a[16][k];
        case 2: return a[5][k];
        case 3: return a[7][k];
        case 4: return k < 1024 ? a[20][k] : (k < 1536 ? a[21][k - 1024] : a[22][k - 1536]);
        case 5: return a[24][k];
        default: return 1.0f;
    }
}
__device__ __forceinline__ void tr_mapn(const InP& a, int mode, int n, int& r, float& cg) {
    cg = 1.0f; r = n;
    switch (mode) {
        case 0:
            if (n < 1024) { r = n; }
            else if (n < 1088) { const int i = n - 1024; r = 2560 + (i < 32 ? i : 128 + (i - 32)); cg = a[12][i]; }
            else if (n < 2112) { r = 1024 + (n - 1088); }
            else { const int j = n - 2112; r = 2048 + j; cg = a[18][j & 127]; }
            break;
        case 1: if (n < 512) cg = a[19][n & 127]; break;
        case 2: { const int h = n / 192, d = n - h * 192;
            if (d < 128) { r = h * 128 + d; cg = a[9][d]; }
            else { const int i = d - 128; r = 1024 + (h >> 2) * 256 + (i < 32 ? 0 : 128) + (h & 3) * 32 + (i & 31); cg = a[10][i]; } } break;
        case 3: { const int h = n >> 8, d = n & 255;
            if (d < 128) { r = h * 128 + d; cg = a[11][d]; } else { r = 1024 + h * 128 + (d - 128); } } break;
        case 5: if (n < 2048) r = (n >> 7) * 256 + (n & 127); else { const int j = n - 2048; r = (j >> 7) * 256 + 128 + (j & 127); } break;
        default: break;
    }
}
__device__ __forceinline__ void tr_item(const InP& a, const float* W, int K, int N, bf16* WT, int mode, LAS float* scr, int item, int lane) {
    const int nblk = N >> 6, kb = item / nblk, nb = item - kb * nblk, k0 = kb << 6, n0 = nb << 6;
#pragma unroll 4
    for (int i = 0; i < 16; ++i) { const int kk = 4 * i + (lane >> 4), nn = (lane & 15) * 4;
        const f32x4 v = *(const f32x4*)(W + (size_t)(k0 + kk) * N + n0 + nn) * tr_kgain(a, mode, k0 + kk);
        LAS float* s = scr + kk * 65 + nn; s[0] = v[0]; s[1] = v[1]; s[2] = v[2]; s[3] = v[3]; }
    asm volatile("s_waitcnt lgkmcnt(0)" ::: "memory");
    const int c = lane & 7;
#pragma unroll
    for (int j = 0; j < 8; ++j) { const int n = (lane >> 3) + 8 * j; int r; float cg; tr_mapn(a, mode, n0 + n, r, cg);
        const LAS float* s = scr + (8 * c) * 65 + n;
        u32x4 o; o.x = cvt_pk_bf16(s[0] * cg, s[65] * cg); o.y = cvt_pk_bf16(s[130] * cg, s[195] * cg); o.z = cvt_pk_bf16(s[260] * cg, s[325] * cg); o.w = cvt_pk_bf16(s[390] * cg, s[455] * cg);
        *(u32x4*)(WT + (size_t)r * K + k0 + 8 * c) = o; }
    asm volatile("s_waitcnt lgkmcnt(0)" ::: "memory");
}
template <int MODE> __device__ __forceinline__ void tr8w_all(const float* Wsrc, unsigned char* Wdst, const float* gain, LAS unsigned char* lds, int bid, int G, int wave, int lane) {
    constexpr int N = MODE == 5 ? 4096 : 2048, NTN = N / 256, PER = 16 * NTN, NIT = 32 * PER, PITCH = 144, BUFB = 256 * PITCH;
    f32x4 vA[16], vB[16];
    int it = bid; if (it >= NIT) return;
#define TR8W_DECODE(IT, WB, OP, K0, N0) const int e_ = (IT) / PER, r_ = (IT) - e_ * PER, K0 = (r_ / NTN) * 128, N0 = (r_ % NTN) * 256; \
        const float* WB = Wsrc + (size_t)e_ * 2048 * N + (size_t)(K0 + 16 * wave) * N + N0; unsigned char* OP = Wdst + (size_t)e_ * N * 2048 + (size_t)(K0 >> 7) * 32768;
    const unsigned voff = (unsigned)lane * 16u;
#define TR8W_LOAD(V, IT) do { const int itc_ = (IT) < NIT ? (IT) : NIT - 1; TR8W_DECODE(itc_, wb_, op_, k0_, n0_); (void)op_; (void)n0_; (void)k0_; \
        _Pragma("unroll") for (int i = 0; i < 16; ++i) { const float* b_ = wb_ + (size_t)i * N; \
            asm volatile("global_load_dwordx4 %0, %1, %2 nt" : "=v"(V[i]) : "v"(voff), "s"(b_) : "memory"); } } while (0)
#define TR8W_WAIT(V) do { if (first) { if (&V[0] == &vA[0]) asm volatile("s_waitcnt vmcnt(16)" ::: "memory"); else asm volatile("s_waitcnt vmcnt(20)" ::: "memory"); } \
        else asm volatile("s_waitcnt vmcnt(24)" ::: "memory");                \
        _Pragma("unroll") for (int i = 0; i < 16; ++i) asm volatile("" : "+v"(V[i])); } while (0)
#define TR8W_PROC(V, IT, PAR) do { TR8W_DECODE(IT, wb, op, k0, n0); (void)wb; \
        unsigned pk[16]; (void)k0; (void)gain;                                 \
        TR8W_WAIT(V); \
        _Pragma("unroll") for (int i = 0; i < 16; ++i) { const f32x4 w = V[i] * 32.0f; \
            int t = __builtin_amdgcn_cvt_pk_fp8_f32(w[0], w[1], 0, false); t = __builtin_amdgcn_cvt_pk_fp8_f32(w[2], w[3], t, true); pk[i] = (unsigned)t; } \
        _Pragma("unroll") for (int i = 0; i < 16; ++i) asm volatile("" : "+v"(pk[i]));     \
        TR8W_LOAD(V, (IT) + 2 * G);                                           \
        u32x4 c[4]; \
        _Pragma("unroll") for (int bq = 0; bq < 4; ++bq) { const unsigned r0 = pk[4 * bq], r1 = pk[4 * bq + 1], r2 = pk[4 * bq + 2], r3 = pk[4 * bq + 3]; \
            const unsigned t0 = __builtin_amdgcn_perm(r1, r0, 0x05010400u), t1 = __builtin_amdgcn_perm(r1, r0, 0x07030602u); \
            const unsigned t2 = __builtin_amdgcn_perm(r3, r2, 0x05010400u), t3 = __builtin_amdgcn_perm(r3, r2, 0x07030602u); \
            c[0][bq] = __builtin_amdgcn_perm(t2, t0, 0x05040100u); c[1][bq] = __builtin_amdgcn_perm(t2, t0, 0x07060302u); \
            c[2][bq] = __builtin_amdgcn_perm(t3, t1, 0x05040100u); c[3][bq] = __builtin_amdgcn_perm(t3, t1, 0x07060302u); } \
        LAS unsigned char* T = lds + (PAR) * BUFB; \
        _Pragma("unroll") for (int j = 0; j < 4; ++j) *(LAS u32x4*)(T + (j * 64 + lane) * PITCH + 16 * wave) = c[j];     \
        asm volatile("s_waitcnt lgkmcnt(0)" ::: "memory"); __builtin_amdgcn_s_barrier(); asm volatile("" ::: "memory"); \
        _Pragma("unroll") for (int q = 0; q < 4; ++q) { const int slot = 32 * wave + 8 * q + (lane >> 3), ch = lane & 7, n = n0 + 4 * (slot & 63) + (slot >> 6); \
            const int r = (MODE == 5) ? (n < 2048 ? (n >> 7) * 256 + (n & 127) : ((n - 2048) >> 7) * 256 + 128 + ((n - 2048) & 127)) : n; \
            const u32x4 w = *(const LAS u32x4*)(T + slot * PITCH + 16 * ch); \
            __builtin_nontemporal_store(w, (u32x4*)(op + (size_t)(r >> 8) * 524288 + (size_t)(r & 255) * 128 + 16 * ch)); } } while (0)
    bool first = true;
    TR8W_LOAD(vA, it); TR8W_LOAD(vB, it + G);
    for (;;) {
        TR8W_PROC(vA, it, 0);
        if (it + G >= NIT) break;
        TR8W_PROC(vB, it + G, 1);
        if (it + 2 * G >= NIT) break;
        it += 2 * G; first = false;
    }
    asm volatile("s_waitcnt vmcnt(0)" ::: "memory");
#pragma unroll
    for (int i = 0; i < 16; ++i) asm volatile("" :: "v"(vA[i]), "v"(vB[i]));
    asm volatile("s_waitcnt lgkmcnt(0)" ::: "memory"); __builtin_amdgcn_s_barrier();
#undef TR8W_DECODE
#undef TR8W_LOAD
#undef TR8W_WAIT
#undef TR8W_PROC
}
__device__ __forceinline__ void row_cvt(const float* xrow, bf16* orow, float* rs, int lane) {
    const f32x4* xr = (const f32x4*)xrow + lane; f32x4 v[8]; float s = 0.f;
#pragma unroll
    for (int j = 0; j < 8; ++j) { v[j] = xr[64 * j]; s += dot4(v[j]); }
    s = wave_sum(s);
    if (lane == 0) *rs = rsqrtf(s * (1.0f / 2048.0f) + EPS);
    u32x2* o8 = (u32x2*)orow + lane;
#pragma unroll
    for (int j = 0; j < 8; ++j) { u32x2 w; w.x = cvt_pk_bf16(v[j][0], v[j][1]); w.y = cvt_pk_bf16(v[j][2], v[j][3]); o8[64 * j] = w; }
}

__global__ void __launch_bounds__(512, 2) fwd_kernel(Args args) {
    extern __shared__ __attribute__((aligned(16))) unsigned char lds_raw[];
    LAS unsigned char* lds = (LAS unsigned char*)lds_raw;
    const int tid = threadIdx.x, lane = tid & 63, wave = __builtin_amdgcn_readfirstlane(tid >> 6);
    const int G = gridDim.x, bid = blockIdx.x;
    unsigned* ctl = (unsigned*)(GAS unsigned*)(args.ws + WS_CTL);
    GAS unsigned char* wsg = (GAS unsigned char*)args.ws;
#define wsp ((unsigned char*)wsg)
#define LAUNDER_WS() asm volatile("" : "+s"(wsg))
#define W1T ((bf16*)(wsp + WS_W1T))
#define WMKVT ((bf16*)(wsp + WS_WMKVT))
#define WQBT ((bf16*)(wsp + WS_WQBT))
#define WKVBT ((bf16*)(wsp + WS_WKVBT))
#define WOT ((bf16*)(wsp + WS_WOT))
#define WSP ((bf16*)(wsp + WS_WSP))
#define WR4 ((float*)(wsp + WS_WR4))
#define WGUT ((unsigned char*)(wsp + WS_WGUT))
#define WDT ((unsigned char*)(wsp + WS_WDT))
#define XB ((bf16*)(wsp + WS_XB))
#define MEMB ((bf16*)(wsp + WS_MEMB))
#define RSTDX ((float*)(wsp + WS_RSTDX))
#define RSTDM ((float*)(wsp + WS_RSTDM))
#define ROPEC ((float*)(wsp + WS_ROPEC))
#define ROPES ((float*)(wsp + WS_ROPES))
#define CQ ((bf16*)(wsp + WS_CQ))
#define CKV ((bf16*)(wsp + WS_CKV))
#define U ((bf16*)(wsp + WS_U))
#define VG ((bf16*)(wsp + WS_VG))
#define QM ((bf16*)(wsp + WS_QM))
#define KPE ((bf16*)(wsp + WS_KPE))
#define MK ((bf16*)(wsp + WS_MK))
#define MV ((bf16*)(wsp + WS_MV))
#define PARTQ ((float*)(wsp + WS_PARTQ))
#define PARTKV ((float*)(wsp + WS_PARTKV))
#define PARTVG ((float*)(wsp + WS_PARTVG))
#define PARTA ((float*)(wsp + WS_PARTA))
#define PARTB ((float*)(wsp + WS_PARTB))
#define PARTM ((float*)(wsp + WS_PARTM))
#define PARTF ((float*)(wsp + WS_PARTF))
#define QBUF ((bf16*)(wsp + WS_QBUF))
#define KBUF ((bf16*)(wsp + WS_KBUF))
#define VBUF ((bf16*)(wsp + WS_VBUF))
#define OC ((bf16*)(wsp + WS_OC))
#define XQ1 ((unsigned char*)(wsp + WS_XB1))
#define LTOK ((int*)(wsp + WS_LTOK))
#define LRS ((float*)(wsp + WS_LRS))
#define LGATE ((float*)(wsp + WS_LGATE))
#define SEL ((int*)(wsp + WS_SEL))
#define ACT ((unsigned char*)(wsp + WS_ACT))
#define Y ((unsigned char*)(wsp + WS_Y))
    float* X1 = (float*)(GAS float*)args.out;

    for (int u = tid; u < 64; u += 512) ((LAS unsigned*)(lds + MISC_OFF))[u] = 0u;
    if (tid < 31) ((LAS unsigned long long*)(lds + PT_OFF))[tid] = (unsigned long long)args.in[tid];
    __syncthreads();
    const InP INP{(const LAS unsigned long long*)(lds + PT_OFF)};
#ifndef CMASK
#define CMASK 0x91224488u
#endif
    const unsigned cmask = (G == 256) ? CMASK : 0u;
    const int NCONV = 8 * __builtin_popcount(cmask), jx = bid >> 3, crank = __builtin_popcount(cmask & ((1u << jx) - 1u));
    const bool is_conv = (cmask >> jx) & 1u;
    const int Gc = G - NCONV, cidx = (jx - crank) * 8 + (bid & 7), vidx = crank * 8 + (bid & 7);
    XcdBarrier bar = xcd_barrier_post(ctl + CW_BAR, (volatile LAS unsigned*)(lds + MISC_OFF) + 8, (unsigned)G);
    XcdBarrier barc = bar;
    if (NCONV && !is_conv) barc = xcd_barrier_post(ctl + CW_BAR + XCD_BAR_WORDS, (volatile LAS unsigned*)(lds + MISC_OFF) + 12, (unsigned)Gc);
    const int lo = args.ph_lo, hi = args.ph_hi;
#ifndef PHASE_MASK
#define PHASE_MASK 0x1ff
#endif
#define IN(k) (((PHASE_MASK >> (k)) & 1) && lo <= (k) && (k) < hi)
#define SEAM(k) do { if (IN(k) && IN((k) + 1)) { if (NCONV && (k) >= 1 && (k) <= 3) { if (!is_conv) xcd_barrier(barc); } else xcd_barrier(bar); } } while (0)

    if (IN(0)) REPS(0) {
        LAUNDER_WS();
        LAS float* scr = (LAS float*)(lds + wave * 16640);
        const int gw = bid * 8 + wave, NGW = G * 8;
        if (!NCONV) { tr8w_all<5>(INP[27], WGUT, INP[24], lds, bid, G, wave, lane); tr8w_all<6>(INP[29], WDT, INP[24], lds, bid, G, wave, lane); }
        for (int it = gw; it < 1312 + 512 + 192 + 256 + 1024; it += NGW) {
            int r = it;
            if (r < 1312) { tr_item(INP, INP[4], 2048, 2624, W1T, 0, scr, r, lane); continue; } r -= 1312;
            if (r < 512) { tr_item(INP, INP[17], 2048, 1024, WMKVT, 1, scr, r, lane); continue; } r -= 512;
            if (r < 192) { tr_item(INP, INP[6], 512, 1536, WQBT, 2, scr, r, lane); continue; } r -= 192;
            if (r < 256) { tr_item(INP, INP[8], 512, 2048, WKVBT, 3, scr, r, lane); continue; } r -= 256;
            tr_item(INP, INP[23], 2048, 2048, WOT, 4, scr, r, lane);
        }
        for (int it = gw; it < 192; it += NGW) { const int rr = it < 96 ? 32 + it : 160 + (it - 96); u32x4* p = (u32x4*)(W1T + (size_t)(2560 + rr) * 2048) + lane;
#pragma unroll
            for (int j = 0; j < 4; ++j) p[64 * j] = (u32x4){0u, 0u, 0u, 0u}; }
        for (int m = gw; m < NTOK; m += NGW) row_cvt(INP[0] + (size_t)m * 2048, XB + (size_t)m * 2048, RSTDX + m, lane);
        for (int m = gw; m < NMROWS; m += NGW) row_cvt(INP[1] + (size_t)m * 2048, MEMB + (size_t)m * 2048, RSTDM + m, lane);
        const int gt = bid * 512 + tid, NGT = G * 512;
        for (int i = gt; i < NTOK * 32; i += NGT) { const int tok = i >> 5, j = i & 31; const float ang = (float)((const int*)INP[2])[tok] * args.invf[j];
            ROPEC[i] = cosf(ang); ROPES[i] = sinf(ang); }
        for (int i = gt; i < 4 * 128 * 128; i += NGT) { const int t = (i >> 7) & 127, s = i & 127; const float w = s <= t ? INP[14][i] : 0.f; WSP[i] = (bf16)(cvt_pk_bf16(w, 0.f) & 0xffffu); }
        for (int i = gt; i < 2048 * 32; i += NGT) { const int k = i >> 5, n = i & 31; WR4[(((k >> 4) * 2 + ((k >> 3) & 1)) * 32 + n) * 8 + (k & 7)] = INP[25][i] * INP[24][k]; }
    }
    SEAM(0);

    if (IN(1) && is_conv) {
        LAUNDER_WS();
        tr8w_all<5>(INP[27], WGUT, INP[24], lds, vidx, NCONV, wave, lane); tr8w_all<6>(INP[29], WDT, INP[24], lds, vidx, NCONV, wave, lane);
    }
    if (IN(1) && !is_conv) REPS(1) {
        LAUNDER_WS();
        Sched1 S{Gc, cidx, XB, W1T, MEMB, WMKVT};
        Epi1 E{RSTDX, RSTDM, ROPEC, ROPES, CQ, CKV, U, VG, QM, KPE, MK, MV, PARTQ, PARTKV, PARTVG};
        pg8::gemm_phase<Epi1, Sched1, false, false>(lds, 32, 4096, 128, 4096, 128, S, E);
    }
    SEAM(1);

    if (IN(2) && !is_conv) REPS(2) {
        LAUNDER_WS();
#ifndef P2_PARTS
#define P2_PARTS 7
#endif
        if (P2_PARTS & 1) { Sched2 S{Gc, cidx, CQ, CKV, WQBT, WKVBT};
          Epi2 E{PARTQ, PARTKV, ROPEC, ROPES, QBUF, KBUF, VBUF};
          pg8::gemm_phase<Epi2, Sched2, false, false>(lds, 8, 1024, 128, 1024, 128, S, E); }
        if (P2_PARTS & 2) {
            LAS unsigned short* T = (LAS unsigned short*)lds;
            LAS float* rsl = (LAS float*)(lds + 40960);
            const int wq = wave & 3, tb = (wave >> 2) * 64, fr = lane & 15, fq = lane >> 4;
            const int p4 = tid & 31, cch = tid >> 5;
            for (int unit = Gc - 1 - cidx; unit < 512; unit += Gc) {
                const int g = unit & 3, cn = unit >> 2, row0 = cn * 128;
                u32x4 vr[4];
#pragma unroll
                for (int r = 0; r < 4; ++r) vr[r] = *(const u32x4*)(VG + (size_t)(row0 + 4 * p4 + r) * 512 + g * 128 + 8 * cch);
                bf16x8 af[4][4];
#pragma unroll
                for (int ks = 0; ks < 4; ++ks)
#pragma unroll
                    for (int m = 0; m < 4; ++m) af[ks][m] = *(const bf16x8*)(WSP + (size_t)(g * 128 + tb + 16 * m + fr) * 128 + ks * 32 + 8 * fq);
                u32x2 uw[4][2]; float bs[4]; f32x4 gv[2];
#pragma unroll
                for (int m = 0; m < 4; ++m) { bs[m] = INP[15][g * 128 + tb + 16 * m + fr];
#pragma unroll
                    for (int n = 0; n < 2; ++n) uw[m][n] = *(const u32x2*)(U + (size_t)(row0 + tb + 16 * m + fr) * 512 + g * 128 + wq * 32 + 16 * n + 4 * fq); }
#pragma unroll
                for (int n = 0; n < 2; ++n) gv[n] = *(const f32x4*)(INP[13] + g * 128 + wq * 32 + 16 * n + 4 * fq);
                if (tid < 128) { float s = 0.f;
#pragma unroll
                    for (int k = 0; k < 8; ++k) s += PARTVG[(size_t)k * NTOK + row0 + tid];
                    rsl[tid] = rsqrtf(s * (1.0f / 512.0f) + EPS); }
                __syncthreads();
                { const f32x4 rs = *(const LAS f32x4*)(rsl + 4 * p4); unsigned nw[4][4];
#pragma unroll
                  for (int r = 0; r < 4; ++r)
#pragma unroll
                    for (int j = 0; j < 4; ++j) { const unsigned x = vr[r][j]; nw[r][j] = cvt_pk_bf16(__uint_as_float(x << 16) * rs[r], __uint_as_float(x & 0xffff0000u) * rs[r]); }
#pragma unroll
                  for (int j = 0; j < 4; ++j) {
                    u32x2 lo, hi;
                    lo.x = __builtin_amdgcn_perm(nw[1][j], nw[0][j], 0x05040100u); lo.y = __builtin_amdgcn_perm(nw[3][j], nw[2][j], 0x05040100u);
                    hi.x = __builtin_amdgcn_perm(nw[1][j], nw[0][j], 0x07060302u); hi.y = __builtin_amdgcn_perm(nw[3][j], nw[2][j], 0x07060302u);
                    *(LAS u32x2*)(T + (8 * cch + 2 * j) * 136 + 4 * p4) = lo; *(LAS u32x2*)(T + (8 * cch + 2 * j + 1) * 136 + 4 * p4) = hi; } }
                __syncthreads();
                f32x4 acc[4][2];
#pragma unroll
                for (int m = 0; m < 4; ++m) { acc[m][0] = (f32x4){0.f, 0.f, 0.f, 0.f}; acc[m][1] = (f32x4){0.f, 0.f, 0.f, 0.f}; }
#pragma unroll
                for (int ks = 0; ks < 4; ++ks) {
                    bf16x8 bfr[2];
#pragma unroll
                    for (int n = 0; n < 2; ++n) bfr[n] = *(const LAS bf16x8*)(T + (wq * 32 + 16 * n + fr) * 136 + ks * 32 + 8 * fq);
#pragma unroll
                    for (int m = 0; m < 4; ++m)
#pragma unroll
                        for (int n = 0; n < 2; ++n) acc[m][n] = __builtin_amdgcn_mfma_f32_16x16x32_bf16(bfr[n], af[ks][m], acc[m][n], 0, 0, 0);
                }
#pragma unroll
                for (int m = 0; m < 4; ++m) { const int t = tb + 16 * m + fr, row = row0 + t; float ss = 0.f;
#pragma unroll
                    for (int n = 0; n < 2; ++n) { const int c = g * 128 + wq * 32 + 16 * n + 4 * fq;
                        const u32x2 w2 = uw[m][n];
                        const f32x4 uv = {__uint_as_float(w2.x << 16), __uint_as_float(w2.x & 0xffff0000u), __uint_as_float(w2.y << 16), __uint_as_float(w2.y & 0xffff0000u)};
                        const f32x4 ov = uv * (acc[m][n] * gv[n] + bs[m]); ss += dot4(ov);
                        u32x2 w; w.x = cvt_pk_bf16(ov[0], ov[1]); w.y = cvt_pk_bf16(ov[2], ov[3]); *(u32x2*)(OC + (size_t)row * 2048 + 1024 + c) = w; }
                    ss = red4(ss); if (fq == 0) PARTB[(size_t)(g * 4 + wq) * NTOK + row] = ss; }
                __syncthreads();
            }
        }
        if (P2_PARTS & 4) for (int it = Gc - 1 - cidx; it < 256; it += Gc) {
            const int bh = (it & 7) * 2 + ((it >> 3) >> 4), qb = (it >> 3) & 15, b = bh >> 2, h = bh & 3; const size_t r0 = (size_t)b * SEQ + qb * 256;
            att::attn_block<128, false>(lds, QM + r0 * 512 + h * 128, 512, MK + (size_t)b * NMEM * 512 + h * 128, 512, nullptr, MV + (size_t)b * NMEM * 512 + h * 128, 512,
                                        OC + r0 * 2048 + 1536 + h * 128, 2048, PARTM + (size_t)h * NTOK + r0, 0, 4);
        }
    }
    SEAM(2);

    if (IN(3) && !is_conv) REPS(3) {
        LAUNDER_WS();
        unsigned long long pat = 0ull; int nblk;
        if (Gc == 184) { const int sl = cidx >> 3;
            if (sl < 16) { const unsigned bs = sl & 3, p = sl >> 2; pat = (bs << 4 | (15 - p)) | ((unsigned long long)(bs << 4 | (7 + p)) << 6); nblk = 2; }
            else if (sl == 16) { pat = (3u << 4 | 11u) | ((unsigned long long)(0u << 4 | 11u) << 6); nblk = 2; }
            else if (sl == 17) { pat = (2u << 4 | 11u) | ((unsigned long long)(1u << 4 | 11u) << 6); nblk = 2; }
            else if (sl < 22) { const unsigned long long bs = (unsigned)(sl - 18) << 4; pat = (bs | 6) | ((bs | 5) << 6) | ((bs | 4) << 12) | ((bs | 2) << 18) | ((bs | 1) << 24); nblk = 5; }
            else { pat = 0ull; for (int q = 0; q < 4; ++q) pat |= ((unsigned long long)(q << 4 | 3) << (6 * q)) | ((unsigned long long)(q << 4 | 0) << (6 * (q + 4))); nblk = 8; } }
        else if (Gc == 192) { const int p = cidx >> 5;
            const unsigned nib = p == 0 ? 0x23Fu : p == 1 ? 0x7Eu : p == 2 ? 0x8Du : p == 3 ? 0x9Cu : p == 4 ? 0xABu : 0x01456u;
            nblk = p == 0 ? 3 : p == 5 ? 5 : 2; for (int q = 0; q < nblk; ++q) pat |= (unsigned long long)((nib >> (4 * q)) & 15u) << (6 * q); }
        else nblk = (512 + Gc - 1) / Gc;
#pragma unroll 1
        for (int r = 0; r < nblk; ++r) {
            int qb, bh;
            if (Gc == 184) { const unsigned en = (unsigned)(pat >> (6 * r)) & 63u; qb = (int)(en & 15u); bh = (int)(en >> 4) * 8 + (cidx & 7); }
            else if (Gc == 192) { qb = (int)((pat >> (6 * r)) & 15u); bh = cidx & 31; }
            else { const int i = r * Gc + ((r & 1) ? Gc - 1 - cidx : cidx); if (i >= 512) continue; qb = 15 - (i >> 5); bh = i & 31; }
            const int b = bh >> 3, h = bh & 7; const size_t r0 = (size_t)b * SEQ + qb * 256;
            att::attn_block<192, true>(lds, QBUF + r0 * 1536 + h * 192, 1536, KBUF + (size_t)b * SEQ * 1024 + h * 128, 1024, KPE + (size_t)b * SEQ * 64,
                                       VBUF + (size_t)b * SEQ * 1024 + h * 128, 1024, OC + r0 * 2048 + h * 128, 2048, PARTA + (size_t)h * NTOK + r0, qb * 256, qb * 4 + 4);
        }
    }
    SEAM(3);

    const bool p4all = NCONV != 0 && G == 256 && IN(3) && IN(4);
    if (p4all && !is_conv && cidx == 0 && tid == 0) __hip_atomic_store(ctl + CW_P3DONE, 1u, __ATOMIC_RELEASE, __HIP_MEMORY_SCOPE_AGENT);
    if (p4all && is_conv) {
        if (tid == 0) { unsigned sp = 0u; while (__hip_atomic_load(ctl + CW_P3DONE, __ATOMIC_RELAXED, __HIP_MEMORY_SCOPE_AGENT) == 0u && ++sp < (1u << 24)) __builtin_amdgcn_s_sleep(2);
            __builtin_amdgcn_fence(__ATOMIC_ACQUIRE, "agent"); }
        __syncthreads();
    }
    if (IN(4) && (!is_conv || p4all)) REPS(4) {
        LAUNDER_WS();
        Sched4 S{p4all ? (is_conv ? NCONV : Gc) : Gc, p4all && is_conv ? 2 * Gc + vidx : cidx, p4all ? 2 : 1 << 20, OC, WOT};
        Epi4 E{PARTA, PARTB, PARTM, INP[24], XB, PARTF, XQ1};
        pg8::gemm_phase<Epi4, Sched4, false, false>(lds, 32, 4096, 128, 4096, 128, S, E);
    }
    SEAM(4);

    if (IN(5) && DBG_LAST_PHASE >= 5) {
        LAUNDER_WS();
        LAS float* LG = (LAS float*)lds;
        LAS int* hist = (LAS int*)(lds + 65536); LAS int* base = hist + 32;
        const int r32 = lane & 31, hi5 = lane >> 5, kq = wave;
        for (int tg = bid; tg < NTOK / 32; tg += G) {
            const int tok0 = tg * 32;
            if (tid < 32) hist[tid] = 0;
            f32x16 acc = {};
            const bf16* xp = XB + (size_t)(tok0 + r32) * 2048 + kq * 256 + 8 * hi5;
            const float* wp = WR4 + ((size_t)(kq * 16 * 2 + hi5) * 32 + r32) * 8;
#pragma unroll 4
            for (int s = 0; s < 16; ++s) { const u32x4 aw = *(const u32x4*)(xp + 16 * s); const f32x4 b0 = *(const f32x4*)(wp + (size_t)s * 512), b1 = *(const f32x4*)(wp + (size_t)s * 512 + 4);
#pragma unroll
                for (int j = 0; j < 4; ++j) { acc = __builtin_amdgcn_mfma_f32_32x32x2f32(__uint_as_float(aw[j] << 16), j < 2 ? b0[2 * j] : b1[2 * j - 4], acc, 0, 0, 0);
                    acc = __builtin_amdgcn_mfma_f32_32x32x2f32(__uint_as_float(aw[j] & 0xffff0000u), j < 2 ? b0[2 * j + 1] : b1[2 * j - 3], acc, 0, 0, 0); } }
#pragma unroll
            for (int r = 0; r < 16; ++r) LG[(kq * 32 + att::crow(r, hi5)) * 33 + r32] = acc[r];
            __syncthreads();
            int se[4] = {0, 0, 0, 0}, sl[4] = {0, 0, 0, 0}; float gate[4] = {0.f, 0.f, 0.f, 0.f}, rs2 = 0.f;
            if (tid < 32) {
                const int tok = tok0 + tid, tl = tid; float ssum = 0.f;
#pragma unroll
                for (int k = 0; k < 32; ++k) ssum += PARTF[(size_t)k * NTOK + tok];
                rs2 = rsqrtf(ssum * (1.0f / 2048.0f) + EPS);
                float v[32];
#pragma unroll
                for (int e = 0; e < 32; ++e) { float s = 0.f;
#pragma unroll
                    for (int q = 0; q < 8; ++q) s += LG[(q * 32 + tl) * 33 + e];
                    v[e] = s * rs2 + INP[26][e]; }
                float tv[4];
#pragma unroll
                for (int k = 0; k < 4; ++k) { float best = -__builtin_inff(); int bi = 0;
#pragma unroll
                    for (int e = 0; e < 32; ++e) if (v[e] > best) { best = v[e]; bi = e; }
#pragma unroll
                    for (int e = 0; e < 32; ++e) v[e] = (e == bi) ? -__builtin_inff() : v[e];
                    se[k] = bi; tv[k] = best; }
                float den = 0.f;
#pragma unroll
                for (int k = 0; k < 4; ++k) { gate[k] = __expf(tv[k] - tv[0]); den += gate[k]; }
                const float inv = 1.0f / den;
#pragma unroll
                for (int k = 0; k < 4; ++k) { gate[k] *= inv; sl[k] = __hip_atomic_fetch_add(hist + se[k], 1, __ATOMIC_RELAXED, __HIP_MEMORY_SCOPE_WORKGROUP); }
            }
            __syncthreads();
            if (tid < 32) { const int hcnt = hist[tid]; base[tid] = hcnt > 0 ? (int)__hip_atomic_fetch_add(ctl + CW_CNT + 64 * tid, (unsigned)hcnt, __ATOMIC_RELAXED, __HIP_MEMORY_SCOPE_AGENT) : 0; }
            __syncthreads();
            if (tid < 32) { const int tok = tok0 + tid;
#pragma unroll
                for (int k = 0; k < 4; ++k) { const int e = se[k], slot = base[e] + sl[k]; LTOK[e * LCAP + slot] = tok; LRS[e * LCAP + slot] = rs2; LGATE[e * LCAP + slot] = gate[k]; SEL[tok * 4 + k] = e * LCAP + slot; } }
            __syncthreads();
        }
    }
    SEAM(5);

#define MOE_TABLES() do { LAS int* T_ = (LAS int*)(lds + MOE_OFF); if (tid < 64) { const int e_ = lane & 31; \
        const int c_ = (int)__hip_atomic_load(ctl + CW_CNT + 64 * e_, __ATOMIC_RELAXED, __HIP_MEMORY_SCOPE_AGENT); int nt_ = (c_ + 255) >> 8, inc_ = nt_; \
        _Pragma("unroll") for (int o_ = 1; o_ < 32; o_ <<= 1) { const int v_ = __shfl_up(inc_, o_); if (e_ >= o_) inc_ += v_; } \
        if (tid < 32) { T_[e_ + 1] = inc_; T_[64 + e_] = (inc_ - nt_) * 256; T_[128 + e_] = c_; if (e_ == 0) T_[0] = 0; } } __syncthreads(); } while (0)

    if (IN(6) && DBG_LAST_PHASE >= 6) REPS(6) {
        LAUNDER_WS();
        MOE_TABLES();
        SchedM<true> S{G, bid, (const LAS int*)(lds + MOE_OFF), XQ1, WGUT, LTOK};
        Epi6 E{LRS, INP[28], ACT};
        pg8::gemm_phase<Epi6, SchedM<true>, true, true>(lds, 16, 2048, 128, 128, 32768, S, E);
    }
    SEAM(6);

    if (IN(7) && DBG_LAST_PHASE >= 7) REPS(7) {
        LAUNDER_WS();
        MOE_TABLES();
        SchedM<false> S{G, bid, (const LAS int*)(lds + MOE_OFF), ACT, WDT, LTOK};
        Epi7 E{LGATE, INP[30], Y};
        pg8::gemm_phase<Epi7, SchedM<false>, true, true>(lds, 16, 128, 32768, 128, 32768, S, E);
    }
    SEAM(7);

    if (IN(8) && DBG_LAST_PHASE >= 8) {
        LAUNDER_WS();
        MOE_TABLES();
        const LAS int* T = (const LAS int*)(lds + MOE_OFF);
        const int gw = bid * 8 + wave, NGW = G * 8;
        for (int tok = gw; tok < NTOK; tok += NGW) {
            const int4 sel = *(const int4*)(SEL + tok * 4); size_t yr[4];
            yr[0] = (size_t)(T[64 + (sel.x >> 14)] + (sel.x & (LCAP - 1))) * 2048; yr[1] = (size_t)(T[64 + (sel.y >> 14)] + (sel.y & (LCAP - 1))) * 2048;
            yr[2] = (size_t)(T[64 + (sel.z >> 14)] + (sel.z & (LCAP - 1))) * 2048; yr[3] = (size_t)(T[64 + (sel.w >> 14)] + (sel.w & (LCAP - 1))) * 2048;
            u32x4 yw[2][4], xw[2][2];
#pragma unroll
            for (int j = 0; j < 2; ++j) {
#pragma unroll
                for (int k = 0; k < 4; ++k) yw[j][k] = *((const u32x4*)(Y + yr[k] + 1024 * j) + lane);
#pragma unroll
                for (int q = 0; q < 2; ++q) xw[j][q] = *((const u32x4*)(XB + (size_t)tok * 2048 + 1024 * j + 16 * lane) + q); }
#pragma unroll
            for (int j = 0; j < 2; ++j)
#pragma unroll
                for (int q = 0; q < 4; ++q) { const unsigned x01 = xw[j][q >> 1][(q & 1) * 2], x23 = xw[j][q >> 1][(q & 1) * 2 + 1];
                    f32x4 v = {__uint_as_float(x01 << 16), __uint_as_float(x01 & 0xffff0000u), __uint_as_float(x23 << 16), __uint_as_float(x23 & 0xffff0000u)};
#pragma unroll
                    for (int k = 0; k < 4; ++k) { const int w = (int)yw[j][k][q];
                        v += (f32x4){__builtin_amdgcn_cvt_f32_fp8(w, 0), __builtin_amdgcn_cvt_f32_fp8(w, 1), __builtin_amdgcn_cvt_f32_fp8(w, 2), __builtin_amdgcn_cvt_f32_fp8(w, 3)} * 0.0625f; }
                    *((f32x4*)(X1 + (size_t)tok * 2048 + 1024 * j + 16 * lane) + q) = v; }
        }
    }
#undef IN
#undef SEAM
#undef W1T
#undef WMKVT
#undef WQBT
#undef WKVBT
#undef WOT
#undef WSP
#undef WR4
#undef WGUT
#undef WDT
#undef XB
#undef MEMB
#undef RSTDX
#undef RSTDM
#undef ROPEC
#undef ROPES
#undef CQ
#undef CKV
#undef U
#undef VG
#undef QM
#undef KPE
#undef MK
#undef MV
#undef PARTQ
#undef PARTKV
#undef PARTVG
#undef PARTA
#undef PARTB
#undef PARTM
#undef PARTF
#undef QBUF
#undef KBUF
#undef VBUF
#undef OC
#undef XQ1
#undef LTOK
#undef LRS
#undef LGATE
#undef SEL
#undef ACT
#undef Y
}

extern "C" void kernel_launch(void* const* d_in, const int* in_sizes, int n_in, void* d_out, int out_size, void* d_ws, size_t ws_size, hipStream_t stream) {
    static int grid = 0;
    if (grid == 0) {
        if (n_in != 31 || out_size != NTOK * DM || ws_size < WS_END) { fprintf(stderr, "kernel_launch: unexpected shapes (n_in %d out %d ws %zu need %zu)\n", n_in, out_size, ws_size, (size_t)WS_END); grid = -1; return; }
        int dev = 0, cus = 0;
        if (hipGetDevice(&dev) != hipSuccess || hipDeviceGetAttribute(&cus, hipDeviceAttributeMultiprocessorCount, dev) != hipSuccess) { grid = -1; return; }
        if (hipFuncSetAttribute((const void*)fwd_kernel, hipFuncAttributeMaxDynamicSharedMemorySize, LDS_BYTES) != hipSuccess) { fprintf(stderr, "kernel_launch: hipFuncSetAttribute failed\n"); grid = -1; return; }
        int per_cu = 0;
        if (hipOccupancyMaxActiveBlocksPerMultiprocessor(&per_cu, (const void*)fwd_kernel, 512, LDS_BYTES) != hipSuccess || per_cu < 1) { fprintf(stderr, "kernel_launch: occupancy query says %d\n", per_cu); }
        (void)hipGetLastError();
        grid = cus > 0 ? cus : 256;
    }
    if (grid < 0) return;
    (void)hipMemsetAsync((char*)d_ws + WS_CTL, 0, CTL_BYTES, stream);
    Args a{};
    for (int i = 0; i < 31; ++i) a.in[i] = (const float*)d_in[i];
    a.out = (float*)d_out; a.ws = (unsigned char*)d_ws;
    for (int i = 0; i < 32; ++i) a.invf[i] = powf(10000.0f, -(float)i / 32.0f);
#if MK_N_LAUNCHES == 1
    a.ph_lo = 0; a.ph_hi = NPHASE;
    hipLaunchKernelGGL(fwd_kernel, dim3(grid), dim3(512), LDS_BYTES, stream, a);
#else
    for (int p = 0; p < NPHASE; ++p) { a.ph_lo = p; a.ph_hi = p + 1; hipLaunchKernelGGL(fwd_kernel, dim3(grid), dim3(512), LDS_BYTES, stream, a); }
#endif
}
```

```cpp
#include <hip/hip_runtime.h>
#include <cstdio>
#include <cstdint>
#include <cmath>

#ifndef MK_N_LAUNCHES
#define MK_N_LAUNCHES 1
#endif
#ifndef DBG_LAST_PHASE
#define DBG_LAST_PHASE 9
#endif
#ifndef DUP_PHASE
#define DUP_PHASE -1
#endif
#define REPS(k) for (int rep_ = 0; rep_ < ((DUP_PHASE == (k)) ? 2 : 1); ++rep_)

#define GAS __attribute__((address_space(1)))
#define LAS __attribute__((address_space(3)))
typedef unsigned short bf16;
typedef short bf16x8 __attribute__((ext_vector_type(8)));
typedef short s16x4 __attribute__((ext_vector_type(4)));
typedef float f32x2 __attribute__((ext_vector_type(2)));
typedef float f32x4 __attribute__((ext_vector_type(4)));
typedef float f32x16 __attribute__((ext_vector_type(16)));
typedef unsigned u32x2 __attribute__((ext_vector_type(2)));
typedef unsigned u32x4 __attribute__((ext_vector_type(4)));
typedef int i32x4 __attribute__((ext_vector_type(4)));
typedef int i32x8 __attribute__((ext_vector_type(8)));

constexpr int NB = 4, SEQ = 4096, DM = 2048, NTOK = NB * SEQ;
constexpr int NMEM = 256, NMROWS = NB * NMEM;
constexpr int N1 = 2816;
constexpr int NE = 32, LCAP = 16384;
constexpr int PMAX = 73728;
constexpr float EPS = 1e-6f;
constexpr int NPHASE = 9;

constexpr size_t al256(size_t x) { return (x + 255) & ~(size_t)255; }
constexpr size_t WS_CTL = 0, CTL_BYTES = 1u << 20;
constexpr size_t WS_W1T = CTL_BYTES;
constexpr size_t WS_WMKVT = WS_W1T + al256((size_t)N1 * 2048 * 2);
constexpr size_t WS_WQBT = WS_WMKVT + al256((size_t)1024 * 2048 * 2);
constexpr size_t WS_WKVBT = WS_WQBT + al256((size_t)1536 * 512 * 2);
constexpr size_t WS_WOT = WS_WKVBT + al256((size_t)2048 * 512 * 2);
constexpr size_t WS_WSP = WS_WOT + al256((size_t)2048 * 2048 * 2);
constexpr size_t WS_WR4 = WS_WSP + al256((size_t)4 * 128 * 128 * 2);
constexpr size_t WS_WGUT = WS_WR4 + al256((size_t)2048 * 32 * 4);
constexpr size_t WS_WDT = WS_WGUT + al256((size_t)NE * 4096 * 2048);
constexpr size_t WS_XB = WS_WDT + al256((size_t)NE * 2048 * 2048);
constexpr size_t WS_MEMB = WS_XB + al256((size_t)NTOK * 2048 * 2);
constexpr size_t WS_RSTDX = WS_MEMB + al256((size_t)NMROWS * 2048 * 2);
constexpr size_t WS_RSTDM = WS_RSTDX + al256((size_t)NTOK * 4);
constexpr size_t WS_ROPEC = WS_RSTDM + al256((size_t)NMROWS * 4);
constexpr size_t WS_ROPES = WS_ROPEC + al256((size_t)NTOK * 32 * 4);
constexpr size_t WS_CQ = WS_ROPES + al256((size_t)NTOK * 32 * 4);
constexpr size_t WS_CKV = WS_CQ + al256((size_t)NTOK * 512 * 2);
constexpr size_t WS_U = WS_CKV + al256((size_t)NTOK * 512 * 2);
constexpr size_t WS_VG = WS_U + al256((size_t)NTOK * 512 * 2);
constexpr size_t WS_QM = WS_VG + al256((size_t)NTOK * 512 * 2);
constexpr size_t WS_KPE = WS_QM + al256((size_t)NTOK * 512 * 2);
constexpr size_t WS_MK = WS_KPE + al256((size_t)NTOK * 64 * 2);
constexpr size_t WS_MV = WS_MK + al256((size_t)NMROWS * 512 * 2);
constexpr size_t WS_PARTQ = WS_MV + al256((size_t)NMROWS * 512 * 2);
constexpr size_t WS_PARTKV = WS_PARTQ + al256((size_t)8 * NTOK * 4);
constexpr size_t WS_PARTVG = WS_PARTKV + al256((size_t)8 * NTOK * 4);
constexpr size_t WS_PARTA = WS_PARTVG + al256((size_t)8 * NTOK * 4);
constexpr size_t WS_PARTB = WS_PARTA + al256((size_t)8 * NTOK * 4);
constexpr size_t WS_PARTM = WS_PARTB + al256((size_t)16 * NTOK * 4);
constexpr size_t WS_PARTF = WS_PARTM + al256((size_t)4 * NTOK * 4);
constexpr size_t WS_QBUF = WS_PARTF + al256((size_t)32 * NTOK * 4);
constexpr size_t WS_KBUF = WS_QBUF + al256((size_t)NTOK * 1536 * 2);
constexpr size_t WS_VBUF = WS_KBUF + al256((size_t)NTOK * 1024 * 2);
constexpr size_t WS_OC = WS_VBUF + al256((size_t)NTOK * 1024 * 2);
constexpr size_t WS_XB1 = WS_OC + al256((size_t)NTOK * 2048 * 2);
constexpr size_t WS_LTOK = WS_XB1 + al256((size_t)NTOK * 2048);
constexpr size_t WS_LRS = WS_LTOK + al256((size_t)NE * LCAP * 4);
constexpr size_t WS_LGATE = WS_LRS + al256((size_t)NE * LCAP * 4);
constexpr size_t WS_SEL = WS_LGATE + al256((size_t)NE * LCAP * 4);
constexpr size_t WS_ACT = WS_SEL + al256((size_t)NTOK * 4 * 4);
constexpr size_t WS_Y = WS_ACT + al256((size_t)PMAX * 2048);
constexpr size_t WS_END = WS_Y + al256((size_t)PMAX * 2048);
constexpr int CW_BAR = 4096;
constexpr int CW_CNT = 16384;

constexpr int RING_BYTES = 131072;
constexpr int EPI_OFF = 131072;
constexpr int S4_OFF = 139264;
constexpr int BIAS_OFF = 139264;
constexpr int ROW_OFF = 155648;
constexpr int MOE_OFF = 157696;
constexpr int MISC_OFF = 158720;
constexpr int PT_OFF = 158976;
constexpr int LDS_BYTES = 163840;
static_assert(S4_OFF + 8192 <= ROW_OFF && BIAS_OFF + 16384 <= ROW_OFF && ROW_OFF + 2048 <= MOE_OFF && MOE_OFF + 1024 <= MISC_OFF && PT_OFF + 256 <= LDS_BYTES && 8 * 16640 <= BIAS_OFF + 16384, "LDS map");

__device__ __forceinline__ unsigned cvt_pk_bf16(float lo, float hi) { unsigned r; asm volatile("v_cvt_pk_bf16_f32 %0, %1, %2" : "=v"(r) : "v"(lo), "v"(hi)); return r; }
__device__ __forceinline__ u32x4 pack8(f32x4 a, f32x4 b) { u32x4 w; w.x = cvt_pk_bf16(a[0], a[1]); w.y = cvt_pk_bf16(a[2], a[3]); w.z = cvt_pk_bf16(b[0], b[1]); w.w = cvt_pk_bf16(b[2], b[3]); return w; }
__device__ __forceinline__ void store8(bf16* p, f32x4 a, f32x4 b) { *(u32x4*)p = pack8(a, b); }
__device__ __forceinline__ u32x2 pack8_fp8(f32x4 a, f32x4 b) { int lo = __builtin_amdgcn_cvt_pk_fp8_f32(a[0], a[1], 0, false); lo = __builtin_amdgcn_cvt_pk_fp8_f32(a[2], a[3], lo, true);
    int hi = __builtin_amdgcn_cvt_pk_fp8_f32(b[0], b[1], 0, false); hi = __builtin_amdgcn_cvt_pk_fp8_f32(b[2], b[3], hi, true); return (u32x2){(unsigned)lo, (unsigned)hi}; }
__device__ __forceinline__ float dot4(f32x4 a) { return (a[0] * a[0] + a[1] * a[1]) + (a[2] * a[2] + a[3] * a[3]); }
__device__ __forceinline__ float red4(float s) { s += __shfl_xor(s, 16); s += __shfl_xor(s, 32); return s; }
__device__ __forceinline__ float wave_sum(float v) {
#pragma unroll
    for (int o = 1; o < 64; o <<= 1) v += __shfl_xor(v, o);
    return v;
}
__device__ __forceinline__ int fresh_lane() { int l; asm volatile("v_mbcnt_lo_u32_b32 %0, -1, 0\n\tv_mbcnt_hi_u32_b32 %0, -1, %0" : "=v"(l)); return l; }
__device__ __forceinline__ float bf2f(unsigned short b) { return __uint_as_float(((unsigned)b) << 16); }
__device__ __forceinline__ f32x2 gelu_pk(f32x2 v) {
    const f32x2 av = __builtin_elementwise_abs(v), d = av * 0.2316418882f + 1.0f;
    f32x2 t; t.x = __builtin_amdgcn_rcpf(d.x); t.y = __builtin_amdgcn_rcpf(d.y);
    f32x2 q = t * 0.5307027145f + (-0.7265760135f); q = q * t + 0.7107068705f; q = q * t + (-0.142248368f); q = q * t + 0.127414796f; q = q * t;
    const f32x2 s = (v * v) * (-0.72134752044f);
    f32x2 e; e.x = __builtin_amdgcn_exp2f(s.x); e.y = __builtin_amdgcn_exp2f(s.y);
    const f32x2 m = v * (q * e), r = v - m;
    f32x2 o; o.x = v.x < 0.f ? m.x : r.x; o.y = v.y < 0.f ? m.y : r.y; return o;
}
__device__ __forceinline__ f32x4 gelu4(f32x4 v) { f32x2 a = gelu_pk((f32x2){v[0], v[1]}), b = gelu_pk((f32x2){v[2], v[3]}); return (f32x4){a.x, a.y, b.x, b.y}; }

struct Args {
    const float* in[31];
    float* out;
    unsigned char* ws;
    float invf[32];
    int ph_lo, ph_hi;
};

namespace pg8 {
constexpr int BM = 256, BK = 64, HALF = 128, HTB = HALF * BK * 2, STAGE_BYTES = 8 * HTB;
__host__ __device__ __forceinline__ int lds_byte(int r, int cb) { return (r >> 3) * 1024 + (r & 7) * 128 + ((((cb >> 4) ^ ((r >> 1) & 7)) << 4) | (cb & 15)); }
__host__ __device__ __forceinline__ void stage_rc(int b, int& R, int& CB) { const int r = (b >> 10) * 8 + ((b >> 7) & 7); R = r; CB = ((((b >> 4) & 7) ^ ((r >> 1) & 7)) << 4) | (b & 15); }
__host__ __device__ __forceinline__ int perm32(int rho) { const int n = rho >> 4, i = rho & 15; return 8 * (i >> 2) + 4 * n + (i & 3); }

template <class Epi, class Sched, bool GATHER, bool FP8>
__device__ __forceinline__ void gemm_phase(LAS unsigned char* lds, const int nt, const int pitchA, const int kstA, const int pitchB, const int kstB, const Sched& S, const Epi& E) {
    typedef typename Sched::Unit Unit;
    const int tid = threadIdx.x, wid = __builtin_amdgcn_readfirstlane(tid >> 6), lane = tid & 63, wr = wid >> 2, wc = wid & 3, fr = lane & 15, fq = lane >> 4;
    unsigned voffA[2], voffB[2]; int RA[2], CA[2];
#pragma unroll
    for (int i = 0; i < 2; ++i) { int R, C; stage_rc(tid * 16 + i * 8192, R, C); const int Rb = (R & ~31) + perm32(R & 31); RA[i] = R; CA[i] = C;
        voffA[i] = (unsigned)(R * pitchA + C); voffB[i] = (unsigned)(Rb * pitchB + C); }
    const size_t kstepA = (size_t)kstA, kstepB = (size_t)kstB;
    const unsigned hstep = (unsigned)HALF * (unsigned)pitchA, hstepB = (unsigned)HALF * (unsigned)pitchB;
    const unsigned ldsw = (unsigned)wid * 1024u;
    const int aoff0 = lds_byte(wr * 64 + fr, fq * 16), aoff1 = lds_byte(wr * 64 + fr, 64 + fq * 16), boff0 = lds_byte(wc * 32 + fr, fq * 16), boff1 = lds_byte(wc * 32 + fr, 64 + fq * 16);
#define PG8_SA(b, h) (((b) * 2 + (h)) * HTB)
#define PG8_SB(b, h) ((4 + (b) * 2 + (h)) * HTB)
#define PG8_STAGE_B(bufoff, gbase) do { _Pragma("unroll") for (int _i = 0; _i < 2; ++_i) { unsigned _o = voffB[_i]; asm volatile("" : "+v"(_o));     \
        __builtin_amdgcn_global_load_lds((const unsigned*)((const char*)(gbase) + _o), (LAS unsigned*)(lds + (bufoff) + ldsw + _i * 8192), 16, 0, 0); } } while (0)
#define PG8_STAGE_A(bufoff, kptr, h) do { _Pragma("unroll") for (int _i = 0; _i < 2; ++_i) { \
        unsigned _o = GATHER ? vC[h][_i] : (voffA[_i] + (unsigned)(h) * hstep); asm volatile("" : "+v"(_o)); \
        __builtin_amdgcn_global_load_lds((const unsigned*)((const char*)(kptr) + _o), (LAS unsigned*)(lds + (bufoff) + ldsw + _i * 8192), 16, 0, 0); } } while (0)
#define PG8_LDA(dst, b, h) do { _Pragma("unroll") for (int m = 0; m < 4; ++m) _Pragma("unroll") for (int k = 0; k < 2; ++k) dst[m][k] = *(const LAS i32x4*)(lds + PG8_SA(b, h) + (k ? aoff1 : aoff0) + m * 2048); } while (0)
#define PG8_LDB(dst, b, h) do { _Pragma("unroll") for (int n = 0; n < 2; ++n) _Pragma("unroll") for (int k = 0; k < 2; ++k) dst[n][k] = *(const LAS i32x4*)(lds + PG8_SB(b, h) + (k ? boff1 : boff0) + n * 2048); } while (0)
#define PG8_MMA(ai, bj, At, Bt) do { __builtin_amdgcn_s_setprio(1); _Pragma("unroll") for (int m = 0; m < 4; ++m) _Pragma("unroll") for (int n = 0; n < 2; ++n) { \
        if constexpr (FP8) { acc[ai][bj][m][n] = __builtin_amdgcn_mfma_scale_f32_16x16x128_f8f6f4(__builtin_shufflevector(Bt[n][0], Bt[n][1], 0, 1, 2, 3, 4, 5, 6, 7), __builtin_shufflevector(At[m][0], At[m][1], 0, 1, 2, 3, 4, 5, 6, 7), \
                acc[ai][bj][m][n], 0, 0, 0, 0, 0, 0); } \
        else { _Pragma("unroll") for (int k = 0; k < 2; ++k) acc[ai][bj][m][n] = __builtin_amdgcn_mfma_f32_16x16x32_bf16(__builtin_bit_cast(bf16x8, Bt[n][k]), __builtin_bit_cast(bf16x8, At[m][k]), acc[ai][bj][m][n], 0, 0, 0); } } \
        __builtin_amdgcn_s_setprio(0); } while (0)
#define PG8_WAIT_V(n) asm volatile("s_waitcnt vmcnt(" #n ")" ::: "memory")
#define PG8_WAIT_L(n) asm volatile("s_waitcnt lgkmcnt(" #n ")" ::: "memory")
#define PG8_BAR __builtin_amdgcn_s_barrier()
#define PG8_SCHED __builtin_amdgcn_sched_barrier(0)
    Unit cur, nxt; int ui = 0;
    if (!S.next(0, cur)) return;
    f32x4 acc[2][2][4][2];
#pragma unroll
    for (int a = 0; a < 2; ++a)
#pragma unroll
        for (int b = 0; b < 2; ++b)
#pragma unroll
            for (int m = 0; m < 4; ++m)
#pragma unroll
                for (int n = 0; n < 2; ++n) acc[a][b][m][n] = (f32x4){0.f, 0.f, 0.f, 0.f};
    i32x4 At[4][2], B0[2][2], B1[2][2];
    const char* cA = cur.A; const char* cB = cur.B;
    unsigned vC[2][2];
    LAS u32x4* stash = (LAS u32x4*)(lds + EPI_OFF) + tid;
    if constexpr (GATHER) {
#pragma unroll
        for (int h = 0; h < 2; ++h)
#pragma unroll
            for (int i = 0; i < 2; ++i) vC[h][i] = S.row_off(cur, h * 128 + RA[i]) + (unsigned)CA[i];
    } else {
#pragma unroll
        for (int h = 0; h < 2; ++h)
#pragma unroll
            for (int i = 0; i < 2; ++i) vC[h][i] = 0u;
    }
    if constexpr (Epi::BEGIN) E.begin(cur, 0, lds);
    int mseq = 0;
    if constexpr (Epi::META) { E.meta_load(cur, 0, lds); E.bias_load(cur, lds); }
    PG8_STAGE_B(PG8_SB(0, 0), cB); PG8_STAGE_B(PG8_SB(0, 1), cB + hstepB); PG8_STAGE_A(PG8_SA(0, 0), cA, 0); PG8_STAGE_A(PG8_SA(0, 1), cA, 1);
    if (wr == 1) PG8_BAR;
    PG8_WAIT_V(2); PG8_BAR;
    PG8_STAGE_B(PG8_SB(1, 0), cB + kstepB); PG8_STAGE_A(PG8_SA(1, 0), cA + kstepA, 0); PG8_STAGE_B(PG8_SB(1, 1), cB + hstepB + kstepB);
    PG8_WAIT_V(6); PG8_BAR;
    for (;;) {
        const bool has_next = S.next(ui + 1, nxt);
        const char* nA = has_next ? nxt.A : cA; const char* nB = has_next ? nxt.B : cB;
        bool nnew = true;
        if constexpr (Epi::META) { nnew = has_next && nxt.newm; if (nnew) E.meta_load(nxt, (mseq + 1) & 1, lds); }
        if constexpr (GATHER) {
            if (has_next && nnew) { const int t2 = wid * 64 + fresh_lane(); u32x4 vn;
#pragma unroll
                for (int i = 0; i < 2; ++i) { int R, C; stage_rc(t2 * 16 + i * 8192, R, C);
#pragma unroll
                    for (int h = 0; h < 2; ++h) vn[h * 2 + i] = S.row_off(nxt, h * 128 + R) + (unsigned)C; }
                *stash = vn; }
        }
        for (int t = 0; t < nt; t += 2) {
            const bool last = (t == nt - 2);
            if constexpr (Epi::KHOOK) E.khook(acc, t, wr, fr, ui, lds);
            const char* a1 = cA + (size_t)(t + 1) * kstepA;
            const char* a2 = last ? nA : cA + (size_t)(t + 2) * kstepA; const char* b2 = last ? nB : cB + (size_t)(t + 2) * kstepB;
            const char* a3 = a2 + kstepA; const char* b3 = b2 + kstepB;
            PG8_LDB(B0, 0, 0); PG8_LDB(B1, 0, 1); PG8_SCHED; PG8_LDA(At, 0, 0); PG8_STAGE_A(PG8_SA(1, 1), a1, 1);
            if constexpr (GATHER) { if (last && has_next && nnew) { const u32x4 vn = *stash; vC[0][0] = vn[0]; vC[0][1] = vn[1]; vC[1][0] = vn[2]; vC[1][1] = vn[3]; } }
            PG8_WAIT_V(8); PG8_WAIT_L(0); PG8_BAR; PG8_MMA(0, 0, At, B0); PG8_MMA(0, 1, At, B1); PG8_BAR; PG8_SCHED;
            PG8_LDA(At, 0, 1); PG8_STAGE_B(PG8_SB(0, 0), b2); PG8_STAGE_B(PG8_SB(0, 1), b2 + hstepB); PG8_STAGE_A(PG8_SA(0, 0), a2, 0);
            PG8_WAIT_V(8); PG8_WAIT_L(0); PG8_BAR; PG8_MMA(1, 0, At, B0); PG8_MMA(1, 1, At, B1); PG8_BAR; PG8_SCHED;
            PG8_LDB(B0, 1, 0); PG8_LDB(B1, 1, 1); PG8_SCHED; PG8_LDA(At, 1, 0); PG8_STAGE_A(PG8_SA(0, 1), a2, 1);
            PG8_WAIT_V(8); PG8_WAIT_L(0); PG8_BAR; PG8_MMA(0, 0, At, B0); PG8_MMA(0, 1, At, B1); PG8_BAR; PG8_SCHED;
            PG8_LDA(At, 1, 1); PG8_STAGE_B(PG8_SB(1, 0), b3); PG8_STAGE_B(PG8_SB(1, 1), b3 + hstepB); PG8_STAGE_A(PG8_SA(1, 0), a3, 0);
            PG8_WAIT_V(8); PG8_WAIT_L(0); PG8_BAR; PG8_MMA(1, 0, At, B0); PG8_MMA(1, 1, At, B1); PG8_BAR; PG8_SCHED;
        }
        if (wr == 0) PG8_BAR;
        { const int l2 = fresh_lane(); E(acc, cur, wr, wc, l2 & 15, l2 >> 4, Epi::META ? mseq : ui, lds); }
        if (!has_next) break;
#pragma unroll
        for (int a = 0; a < 2; ++a)
#pragma unroll
            for (int b = 0; b < 2; ++b)
#pragma unroll
                for (int m = 0; m < 4; ++m)
#pragma unroll
                    for (int n = 0; n < 2; ++n) acc[a][b][m][n] = (f32x4){0.f, 0.f, 0.f, 0.f};
        if constexpr (Epi::META) { if (nnew) { ++mseq; if (nxt.e != cur.e) { PG8_BAR; E.bias_load(nxt, lds); } } }
        cur = nxt; cA = nA; cB = nB; ++ui;
        if constexpr (Epi::BEGIN) E.begin(cur, ui, lds);
        if (wr == 1) PG8_BAR;
    }
    PG8_WAIT_V(0);
    PG8_BAR;
#undef PG8_SA
#undef PG8_SB
#undef PG8_STAGE_A
#undef PG8_STAGE_B
#undef PG8_LDA
#undef PG8_LDB
#undef PG8_MMA
#undef PG8_WAIT_V
#undef PG8_WAIT_L
#undef PG8_BAR
#undef PG8_SCHED
}
}

typedef f32x4 AccT[2][2][4][2];
#define ROWL(ai, m) (128 * (ai) + 64 * wr + 16 * (m) + fr)
#define COLL(bj) (128 * (bj) + 32 * wc + 8 * fq)

__device__ __forceinline__ void normalize_halves(AccT& acc, LAS unsigned char* lds, int wr, int wc, int fr, int fq, bool apply) {
    LAS float* P = (LAS float*)(lds + EPI_OFF);
    float r[2][4][2];
    if (apply) {
#pragma unroll
        for (int ai = 0; ai < 2; ++ai)
#pragma unroll
            for (int m = 0; m < 4; ++m)
#pragma unroll
                for (int bj = 0; bj < 2; ++bj) { float s = dot4(acc[ai][bj][m][0]) + dot4(acc[ai][bj][m][1]); s = red4(s);
                    if (fq == 0) P[(bj * 256 + ROWL(ai, m)) * 4 + wc] = s; }
        asm volatile("s_waitcnt lgkmcnt(0)" ::: "memory"); __builtin_amdgcn_s_barrier(); asm volatile("" ::: "memory");
#pragma unroll
        for (int ai = 0; ai < 2; ++ai)
#pragma unroll
            for (int m = 0; m < 4; ++m)
#pragma unroll
                for (int bj = 0; bj < 2; ++bj) { const f32x4 p = *(const LAS f32x4*)(P + (bj * 256 + ROWL(ai, m)) * 4);
                    r[ai][m][bj] = rsqrtf(((p[0] + p[1]) + (p[2] + p[3])) * (1.0f / 128.0f) + EPS); }
        asm volatile("s_waitcnt lgkmcnt(0)" ::: "memory");
    } else {
#pragma unroll
        for (int ai = 0; ai < 2; ++ai)
#pragma unroll
            for (int m = 0; m < 4; ++m) { r[ai][m][0] = 1.0f; r[ai][m][1] = 1.0f; }
    }
#pragma unroll
    for (int ai = 0; ai < 2; ++ai)
#pragma unroll
        for (int m = 0; m < 4; ++m)
#pragma unroll
            for (int bj = 0; bj < 2; ++bj) { float f = r[ai][m][bj]; asm volatile("" : "+v"(f)); acc[ai][bj][m][0] *= f; acc[ai][bj][m][1] *= f; }
}
__device__ __forceinline__ void rope_rows(AccT& acc, int row0, int wr, int fr, int fq, const float* RC, const float* RS, bf16* dst, int pitch, int coloff) {
#pragma unroll
    for (int ai = 0; ai < 2; ++ai)
#pragma unroll
        for (int m = 0; m < 4; ++m) {
            const int row = row0 + ROWL(ai, m);
            float s = dot4(acc[ai][0][m][0]) + dot4(acc[ai][0][m][1]) + dot4(acc[ai][1][m][0]) + dot4(acc[ai][1][m][1]); s = red4(s);
            const float r = rsqrtf(s * (1.0f / 64.0f) + EPS);
            const f32x4 c0 = *(const f32x4*)(RC + (size_t)row * 32 + 8 * fq), c1 = *(const f32x4*)(RC + (size_t)row * 32 + 8 * fq + 4);
            const f32x4 s0 = *(const f32x4*)(RS + (size_t)row * 32 + 8 * fq), s1 = *(const f32x4*)(RS + (size_t)row * 32 + 8 * fq + 4);
            const f32x4 a0 = acc[ai][0][m][0] * r, a1 = acc[ai][0][m][1] * r, b0 = acc[ai][1][m][0] * r, b1 = acc[ai][1][m][1] * r;
            bf16* d = dst + (size_t)row * pitch + coloff + 8 * fq;
            store8(d, a0 * c0 - b0 * s0, a1 * c1 - b1 * s1);
            store8(d + 32, a0 * s0 + b0 * c0, a1 * s1 + b1 * c1);
            asm volatile("" ::: "memory");
        }
}

struct UnitG { const char* A; const char* B; int pm, pn, kind; };
struct Sched1 {
    typedef UnitG Unit;
    int G, c; const bf16 *XB, *W1T, *MEMB, *WMKVT;
    __device__ __forceinline__ bool next(int i, Unit& u) const {
        const int L = i * G + c; if (L >= 720) return false;
        if (L < 704) { const int g8 = L / 88, r = L - g8 * 88; u.pm = g8 * 8 + (r & 7); u.pn = r >> 3; u.kind = 0;
            u.A = (const char*)(XB + (size_t)u.pm * 256 * 2048); u.B = (const char*)(W1T + (size_t)u.pn * 256 * 2048); }
        else { const int r = L - 704; u.pm = r >> 2; u.pn = r & 3; u.kind = 1;
            u.A = (const char*)(MEMB + (size_t)u.pm * 256 * 2048); u.B = (const char*)(WMKVT + (size_t)u.pn * 256 * 2048); }
        return true;
    }
};
struct Epi1 {
    static constexpr bool KHOOK = false, BEGIN = false, META = false;
    const float *rstdx, *rstdm, *RC, *RS; bf16 *CQ, *CKV, *U, *VG, *QM, *KPE, *MK, *MV; float *PARTQ, *PARTKV, *PARTVG;
    __device__ __forceinline__ void operator()(AccT& acc, const UnitG& u, int wr, int wc, int fr, int fq, int, LAS unsigned char* lds) const {
        const int row0 = u.pm * 256, pn = u.pn; const float* rsp = (u.kind ? rstdm : rstdx) + row0;
#pragma unroll
        for (int ai = 0; ai < 2; ++ai)
#pragma unroll
            for (int m = 0; m < 4; ++m) { const float rs = rsp[ROWL(ai, m)];
#pragma unroll
                for (int bj = 0; bj < 2; ++bj) { acc[ai][bj][m][0] *= rs; acc[ai][bj][m][1] *= rs; } }
        asm volatile("" ::: "memory");
        normalize_halves(acc, lds, wr, wc, fr, fq, (u.kind == 1 && pn < 2) || (u.kind == 0 && pn >= 8 && pn < 10));
        if (u.kind == 1 || (pn >= 8 && pn < 10)) {
            bf16* dst = u.kind == 1 ? (pn < 2 ? MK + pn * 256 : MV + (pn - 2) * 256) : QM + (pn - 8) * 256;
            dst += 32 * wc + 8 * fq;
#pragma unroll
            for (int ai = 0; ai < 2; ++ai)
#pragma unroll
                for (int m = 0; m < 4; ++m) {
#pragma unroll
                    for (int bj = 0; bj < 2; ++bj) store8(dst + (size_t)(row0 + ROWL(ai, m)) * 512 + 128 * bj, acc[ai][bj][m][0], acc[ai][bj][m][1]);
                    asm volatile("" ::: "memory"); }
            return;
        }
        if (pn < 4) {
            bf16* dst = (pn < 2 ? CQ : CKV) + (pn & 1) * 256 + 32 * wc + 8 * fq; float* part = (pn < 2 ? PARTQ : PARTKV) + (size_t)((pn & 1) * 4 + wc) * NTOK;
#pragma unroll
            for (int ai = 0; ai < 2; ++ai)
#pragma unroll
                for (int m = 0; m < 4; ++m) { const int row = row0 + ROWL(ai, m); float ss = 0.f;
#pragma unroll
                    for (int bj = 0; bj < 2; ++bj) { ss += dot4(acc[ai][bj][m][0]) + dot4(acc[ai][bj][m][1]); store8(dst + (size_t)row * 512 + 128 * bj, acc[ai][bj][m][0], acc[ai][bj][m][1]); }
                    ss = red4(ss); if (fq == 0) part[row] = ss;
                    asm volatile("" ::: "memory"); }
        } else if (pn < 8) {
            bf16* dst = (pn < 6 ? U : VG) + (pn & 1) * 256 + 32 * wc + 8 * fq; float* part = PARTVG + (size_t)((pn & 1) * 4 + wc) * NTOK;
#pragma unroll
            for (int ai = 0; ai < 2; ++ai)
#pragma unroll
                for (int m = 0; m < 4; ++m) { const int row = row0 + ROWL(ai, m); float ss = 0.f;
#pragma unroll
                    for (int bj = 0; bj < 2; ++bj) { const f32x4 g0 = gelu4(acc[ai][bj][m][0]), g1 = gelu4(acc[ai][bj][m][1]); ss += dot4(g0) + dot4(g1); store8(dst + (size_t)row * 512 + 128 * bj, g0, g1); }
                    ss = red4(ss); if (pn >= 6 && fq == 0) part[row] = ss;
                    asm volatile("" ::: "memory"); }
        } else {
            if (wc == 0) rope_rows(acc, row0, wr, fr, fq, RC, RS, KPE, 64, 0);
        }
    }
};

struct Sched2 {
    typedef UnitG Unit;
    int G, c; const bf16 *CQ, *CKV, *WQBT, *WKVBT;
    __device__ __forceinline__ bool next(int i, Unit& u) const {
        const int L = i * G + c; if (L >= 896) return false;
        const int g8 = L / 112, r = L - g8 * 112; u.pm = g8 * 8 + (r & 7); const int pn = r >> 3;
        if (pn < 6) { u.kind = 0; u.pn = pn; u.A = (const char*)(CQ + (size_t)u.pm * 256 * 512); u.B = (const char*)(WQBT + (size_t)pn * 256 * 512); }
        else { u.kind = 1; u.pn = pn - 6; u.A = (const char*)(CKV + (size_t)u.pm * 256 * 512); u.B = (const char*)(WKVBT + (size_t)(pn - 6) * 256 * 512); }
        return true;
    }
};
struct Epi2 {
    static constexpr bool KHOOK = false, BEGIN = true, META = false;
    const float *PARTQ, *PARTKV, *RC, *RS; bf16 *QBUF, *KBUF, *VBUF;
    __device__ __forceinline__ void begin(const UnitG& u, int ui, LAS unsigned char* lds) const {
        if (threadIdx.x < 256) {
            LAS float* S4 = (LAS float*)(lds + S4_OFF) + (ui & 1) * 1024;
            const float* part = (u.kind ? PARTKV : PARTQ) + u.pm * 256 + threadIdx.x; float s = 0.f;
#pragma unroll
            for (int k = 0; k < 8; ++k) s += part[(size_t)k * NTOK];
            S4[threadIdx.x * 4] = rsqrtf(s * (1.0f / 512.0f) + EPS);
        }
    }
    __device__ __forceinline__ void operator()(AccT& acc, const UnitG& u, int wr, int wc, int fr, int fq, int ui, LAS unsigned char* lds) const {
        const LAS float* S4 = (const LAS float*)(lds + S4_OFF) + (ui & 1) * 1024;
        const int row0 = u.pm * 256, pn = u.pn;
#pragma unroll
        for (int ai = 0; ai < 2; ++ai)
#pragma unroll
            for (int m = 0; m < 4; ++m) { const float rs = S4[ROWL(ai, m) * 4];
#pragma unroll
                for (int bj = 0; bj < 2; ++bj) { acc[ai][bj][m][0] *= rs; acc[ai][bj][m][1] *= rs; } }
        normalize_halves(acc, lds, wr, wc, fr, fq, pn < 4);
        if (u.kind == 0 && pn >= 4) {
            const int h = 4 * (pn - 4) + wc;
            rope_rows(acc, row0, wr, fr, fq, RC, RS, QBUF, 1536, h * 192 + 128);
            return;
        }
        bf16* dst; int pitch, hs;
        if (u.kind == 0) { dst = QBUF + (2 * pn) * 192; pitch = 1536; hs = 192; }
        else if (pn < 4) { dst = KBUF + (2 * pn) * 128; pitch = 1024; hs = 128; }
        else { dst = VBUF + (2 * (pn - 4)) * 128; pitch = 1024; hs = 128; }
        dst += 32 * wc + 8 * fq;
#pragma unroll
        for (int ai = 0; ai < 2; ++ai)
#pragma unroll
            for (int m = 0; m < 4; ++m) {
#pragma unroll
                for (int bj = 0; bj < 2; ++bj) store8(dst + (size_t)(row0 + ROWL(ai, m)) * pitch + bj * hs, acc[ai][bj][m][0], acc[ai][bj][m][1]);
                asm volatile("" ::: "memory"); }
    }
};

struct Sched4 {
    typedef UnitG Unit;
    int G, c; const bf16 *OC, *WOT;
    __device__ __forceinline__ bool next(int i, Unit& u) const {
        const int L = i * G + c; if (L >= 512) return false;
        const int g8 = L >> 6, r = L & 63; u.pm = g8 * 8 + (r & 7); u.pn = r >> 3; u.kind = 0;
        u.A = (const char*)(OC + (size_t)u.pm * 256 * 2048); u.B = (const char*)(WOT + (size_t)u.pn * 256 * 2048); return true;
    }
};
struct Epi4 {
    static constexpr bool KHOOK = true, BEGIN = true, META = false;
    const float *PARTA, *PARTB, *PARTM, *fgain; bf16* xb; float* PARTF; unsigned char* XQ1;
    __device__ __forceinline__ void begin(const UnitG& u, int ui, LAS unsigned char* lds) const {
        if (threadIdx.x < 256) {
            LAS float* S4 = (LAS float*)(lds + S4_OFF) + (ui & 1) * 1024;
            const int row = u.pm * 256 + threadIdx.x; float sa = 0.f, sb = 0.f, sc = 0.f;
#pragma unroll
            for (int k = 0; k < 8; ++k) sa += PARTA[(size_t)k * NTOK + row];
#pragma unroll
            for (int k = 0; k < 16; ++k) sb += PARTB[(size_t)k * NTOK + row];
#pragma unroll
            for (int k = 0; k < 4; ++k) sc += PARTM[(size_t)k * NTOK + row];
            const float rA = rsqrtf(sa * (1.0f / 1024.0f) + EPS), rB = rsqrtf(sb * (1.0f / 512.0f) + EPS), rC = rsqrtf(sc * (1.0f / 512.0f) + EPS);
            *(LAS f32x4*)(S4 + threadIdx.x * 4) = (f32x4){rA / rB, rB / rC, rC, 0.f};
        }
    }
    __device__ __forceinline__ void khook(AccT& acc, int t, int wr, int fr, int ui, LAS unsigned char* lds) const {
        if (t == 16 || t == 24) {
            const LAS float* S4 = (const LAS float*)(lds + S4_OFF) + (ui & 1) * 1024 + (t == 16 ? 0 : 1);
#pragma unroll
            for (int ai = 0; ai < 2; ++ai)
#pragma unroll
                for (int m = 0; m < 4; ++m) { const float f = S4[ROWL(ai, m) * 4];
#pragma unroll
                    for (int bj = 0; bj < 2; ++bj) { acc[ai][bj][m][0] *= f; acc[ai][bj][m][1] *= f; } }
        }
    }
    __device__ __forceinline__ void operator()(AccT& acc, const UnitG& u, int wr, int wc, int fr, int fq, int ui, LAS unsigned char* lds) const {
        const LAS float* S4 = (const LAS float*)(lds + S4_OFF) + (ui & 1) * 1024;
        const int row0 = u.pm * 256, col0 = u.pn * 256; float* part = PARTF + (size_t)(u.pn * 4 + wc) * NTOK;
        u32x4 xw[2][4][2];
#define EPI4_LD(ai, m) do { _Pragma("unroll") for (int bj = 0; bj < 2; ++bj) xw[ai][m][bj] = *(const u32x4*)(xb + (size_t)(row0 + ROWL(ai, m)) * 2048 + col0 + COLL(bj)); } while (0)
#define EPI4_ROW(ai, m) do { const int row = row0 + ROWL(ai, m); const float rC = S4[ROWL(ai, m) * 4 + 2]; float ss = 0.f; \
        _Pragma("unroll") for (int bj = 0; bj < 2; ++bj) { const size_t o = (size_t)row * 2048 + col0 + COLL(bj); const u32x4 w = xw[ai][m][bj]; \
            const f32x4 x0 = {__uint_as_float(w[0] << 16), __uint_as_float(w[0] & 0xffff0000u), __uint_as_float(w[1] << 16), __uint_as_float(w[1] & 0xffff0000u)}; \
            const f32x4 x1 = {__uint_as_float(w[2] << 16), __uint_as_float(w[2] & 0xffff0000u), __uint_as_float(w[3] << 16), __uint_as_float(w[3] & 0xffff0000u)}; \
            const f32x4 o0 = x0 + acc[ai][bj][m][0] * rC, o1 = x1 + acc[ai][bj][m][1] * rC; \
            *(u32x4*)(xb + o) = (u32x4){cvt_pk_bf16(o0[0], o0[1]), cvt_pk_bf16(o0[2], o0[3]), cvt_pk_bf16(o1[0], o1[1]), cvt_pk_bf16(o1[2], o1[3])}; \
            *(u32x2*)(XQ1 + o) = pack8_fp8(o0 * fg[bj][0], o1 * fg[bj][1]); ss += dot4(o0) + dot4(o1); } \
        ss = red4(ss); if (fq == 0) part[row] = ss; asm volatile("" ::: "memory"); } while (0)
        EPI4_LD(0, 0); EPI4_LD(0, 1); EPI4_LD(0, 2); EPI4_LD(0, 3); EPI4_LD(1, 0); EPI4_LD(1, 1);
        f32x4 fg[2][2];
#pragma unroll
        for (int bj = 0; bj < 2; ++bj) { fg[bj][0] = *(const f32x4*)(fgain + col0 + COLL(bj)); fg[bj][1] = *(const f32x4*)(fgain + col0 + COLL(bj) + 4); }
        asm volatile("" ::: "memory");
        EPI4_ROW(0, 0); EPI4_LD(1, 2); EPI4_ROW(0, 1); EPI4_LD(1, 3); EPI4_ROW(0, 2); EPI4_ROW(0, 3);
        EPI4_ROW(1, 0); EPI4_ROW(1, 1); EPI4_ROW(1, 2); EPI4_ROW(1, 3);
#undef EPI4_LD
#undef EPI4_ROW
    }
};

struct UnitM { const char* A; const char* B; int pn, e, mtl, cnt, pstart; bool newm; };
template <bool UP> struct SchedM {
    typedef UnitM Unit;
    int G, c; const LAS int* T;
    const unsigned char *Amat, *Wt; const int* LTOK;
    static constexpr int NPN = UP ? 16 : 8;
    __device__ __forceinline__ void where(int i, int& mt, int& pn) const {
        if (G == 256) { if (i < NPN) { mt = 32 * (c & 7) + (c >> 3); pn = i; } else { const int L = c + 256 * (i - NPN); mt = 256 + L / NPN; pn = L % NPN; } }
        else { const int L = i * G + c; mt = L / NPN; pn = L - mt * NPN; }
    }
    __device__ __forceinline__ bool next(int i, Unit& u) const {
        int mt, pnn; where(i, mt, pnn);
        if (mt >= __builtin_amdgcn_readfirstlane(T[32])) return false;
        int mtp = -1, pnp; if (i > 0) where(i - 1, mtp, pnp); (void)pnp;
        const int lane = fresh_lane();
        const unsigned long long bal = __ballot(lane < 32 && mt >= T[(lane & 31) + 1]);
        const int e = __builtin_popcountll(bal);
        u.pn = pnn; u.e = e; u.newm = (mt != mtp);
        u.mtl = mt - __builtin_amdgcn_readfirstlane(T[e]); u.cnt = __builtin_amdgcn_readfirstlane(T[128 + e]); u.pstart = __builtin_amdgcn_readfirstlane(T[64 + e]);
        u.A = (const char*)Amat;
        u.B = (const char*)(Wt + ((size_t)e * NPN + (size_t)u.pn) * 524288);
        return true;
    }
    __device__ __forceinline__ unsigned row_off(const Unit& u, int rl) const {
        const int slot = u.mtl * 256 + rl;
        if (UP) { const int tok = slot < u.cnt ? LTOK[u.e * LCAP + slot] : 0; return (unsigned)tok * 2048u; }
        else return (unsigned)(((u.pstart >> 8) + u.mtl) * 16 * 256 + rl) * 128u;
    }
};
struct Epi6 {
    static constexpr bool KHOOK = false, BEGIN = false, META = true;
    const float *LRS, *BGU; unsigned char* ACT;
    __device__ __forceinline__ void meta_load(const UnitM& u, int par, LAS unsigned char* lds) const {
        if (threadIdx.x < 256) { const int slot = u.mtl * 256 + threadIdx.x;
            ((LAS float*)(lds + ROW_OFF))[par * 256 + threadIdx.x] = slot < u.cnt ? LRS[u.e * LCAP + slot] * 0.03125f : 0.f; }
    }
    __device__ __forceinline__ void bias_load(const UnitM& u, LAS unsigned char* lds) const {
        const f32x4* src = (const f32x4*)(BGU + (size_t)u.e * 4096) + threadIdx.x; LAS f32x4* dst = (LAS f32x4*)(lds + BIAS_OFF) + threadIdx.x;
        dst[0] = src[0]; dst[512] = src[512];
    }
    __device__ __forceinline__ void operator()(AccT& acc, const UnitM& u, int wr, int wc, int fr, int fq, int mseq, LAS unsigned char* lds) const {
        const int colg = u.pn * 128 + 32 * wc + 8 * fq; const LAS float* bg = (const LAS float*)(lds + BIAS_OFF) + colg; const LAS float* rowf = (const LAS float*)(lds + ROW_OFF) + (mseq & 1) * 256;
        const f32x4 bg0 = *(const LAS f32x4*)bg, bg1 = *(const LAS f32x4*)(bg + 4), bu0 = *(const LAS f32x4*)(bg + 2048), bu1 = *(const LAS f32x4*)(bg + 2052);
#pragma unroll
        for (int ai = 0; ai < 2; ++ai)
#pragma unroll
            for (int m = 0; m < 4; ++m) { const int slot = u.mtl * 256 + ROWL(ai, m); const float rs = rowf[ROWL(ai, m)];
                f32x4 g[2] = {acc[ai][0][m][0] * rs + bg0, acc[ai][0][m][1] * rs + bg1}, up[2] = {acc[ai][1][m][0] * rs + bu0, acc[ai][1][m][1] * rs + bu1}, a[2];
#pragma unroll
                for (int n = 0; n < 2; ++n)
#pragma unroll
                    for (int j = 0; j < 4; ++j) { const float gg = fminf(g[n][j], 7.0f), uu = fminf(fmaxf(up[n][j], -7.0f), 7.0f);
                        const float sg = __builtin_amdgcn_rcpf(1.0f + __builtin_amdgcn_exp2f(gg * (-1.702f * 1.4426950408889634f)));
                        a[n][j] = (uu + 1.0f) * (gg * sg); }
                *(u32x2*)(ACT + ((size_t)(((u.pstart >> 8) + u.mtl) * 16 + u.pn) * 256 + ROWL(ai, m)) * 128 + 32 * wc + 8 * fq) = pack8_fp8(a[0], a[1]);
                asm volatile("" ::: "memory"); }
    }
};
struct Epi7 {
    static constexpr bool KHOOK = false, BEGIN = false, META = true;
    const float *LGATE, *BD; unsigned char* Y;
    __device__ __forceinline__ void meta_load(const UnitM& u, int par, LAS unsigned char* lds) const {
        if (threadIdx.x < 256) { const int slot = u.mtl * 256 + threadIdx.x;
            ((LAS float*)(lds + ROW_OFF))[par * 256 + threadIdx.x] = slot < u.cnt ? LGATE[u.e * LCAP + slot] * 16.0f : 0.f; }
    }
    __device__ __forceinline__ void bias_load(const UnitM& u, LAS unsigned char* lds) const {
        ((LAS f32x4*)(lds + BIAS_OFF))[threadIdx.x] = ((const f32x4*)(BD + (size_t)u.e * 2048))[threadIdx.x];
    }
    __device__ __forceinline__ void operator()(AccT& acc, const UnitM& u, int wr, int wc, int fr, int fq, int mseq, LAS unsigned char* lds) const {
        const int col = u.pn * 256 + 32 * wc + 8 * fq; const LAS float* bp = (const LAS float*)(lds + BIAS_OFF) + col; const LAS float* rowf = (const LAS float*)(lds + ROW_OFF) + (mseq & 1) * 256;
        const f32x4 b00 = *(const LAS f32x4*)bp, b01 = *(const LAS f32x4*)(bp + 4), b10 = *(const LAS f32x4*)(bp + 128), b11 = *(const LAS f32x4*)(bp + 132);
#pragma unroll
        for (int ai = 0; ai < 2; ++ai)
#pragma unroll
            for (int m = 0; m < 4; ++m) { const int slot = u.mtl * 256 + ROWL(ai, m); const float gt = rowf[ROWL(ai, m)];
                unsigned char* yp = Y + ((size_t)u.pstart + slot) * 2048 + col;
                *(u32x2*)yp = pack8_fp8((acc[ai][0][m][0] * 0.03125f + b00) * gt, (acc[ai][0][m][1] * 0.03125f + b01) * gt);
                *(u32x2*)(yp + 128) = pack8_fp8((acc[ai][1][m][0] * 0.03125f + b10) * gt, (acc[ai][1][m][1] * 0.03125f + b11) * gt);
                asm volatile("" ::: "memory"); }
    }
};

namespace att {
constexpr int SHM_V = 64 * 128 * 2;
__device__ __forceinline__ int v_st(int k, int c) { const int kk = (k & ~0xC) | ((k & 4) << 1) | ((k & 8) >> 1); return ((kk >> 3) * 4 + (c >> 5)) * 512 + ((kk & 7) * 32 + (c & 31)) * 2; }
__device__ __forceinline__ int v_rd_base(int lane) { return ((lane & 3) << 3) | (((lane >> 2) & 3) << 6) | (((lane >> 4) & 1) << 5) | (((lane >> 5) & 1) << 8); }
constexpr int v_rd_off(int d0, int ks, int half) { return d0 * 512 + ks * 4096 + half * 2048; }
__device__ __forceinline__ int crow(int r, int hi) { return (r & 3) + 8 * (r >> 2) + 4 * hi; }
__device__ __forceinline__ void mask_tile(f32x16& p0, f32x16& p1, int dq) {
    const float NEG = -__builtin_inff();
#pragma unroll
    for (int r = 0; r < 16; ++r) { const int c = (r & 3) + 8 * (r >> 2);
        if (dq - c < 0) p0[r] = NEG;
        if (dq - c - 32 < 0) p1[r] = NEG; }
}
template <int DK> __device__ __forceinline__ void partialSM(f32x16& p0, f32x16& p1, float& m_reg, float& mn, float& alpha) {
    constexpr float SCALE = DK == 192 ? 0.07216878364870322f : 0.08838834764831845f, THR = 8.f;
    float pmax = p0[0];
#pragma unroll
    for (int r = 1; r < 16; ++r) pmax = fmaxf(pmax, p0[r]);
#pragma unroll
    for (int r = 0; r < 16; ++r) pmax = fmaxf(pmax, p1[r]);
    { auto rr = __builtin_amdgcn_permlane32_swap(__float_as_uint(pmax), __float_as_uint(pmax), false, false);
      pmax = fmaxf(__uint_as_float(rr[0]), __uint_as_float(rr[1])); }
    constexpr float C2 = 1.4426950408889634f * SCALE;
    if (__builtin_expect(__all((pmax - m_reg) * SCALE <= THR), 1)) { mn = m_reg; alpha = 1.f; }
    else { mn = fmaxf(m_reg, pmax); alpha = __builtin_amdgcn_exp2f((m_reg - mn) * C2); m_reg = mn; }
    const float mnL = -mn * C2;
#pragma unroll
    for (int r = 0; r < 16; ++r) p0[r] = fmaf(p0[r], C2, mnL);
#pragma unroll
    for (int r = 0; r < 16; ++r) p1[r] = fmaf(p1[r], C2, mnL);
#pragma unroll
    for (int r = 0; r < 16; ++r) p0[r] = __builtin_amdgcn_exp2f(p0[r]);
}
__device__ __forceinline__ void finishSM(f32x16& p0, f32x16& p1, float alpha, float& l_reg, bf16x8& pa0, bf16x8& pa1, bf16x8& pa2, bf16x8& pa3) {
#pragma unroll
    for (int r = 0; r < 16; ++r) p1[r] = __builtin_amdgcn_exp2f(p1[r]);
    float ps = 0;
#pragma unroll
    for (int r = 0; r < 16; ++r) ps += p0[r];
#pragma unroll
    for (int r = 0; r < 16; ++r) ps += p1[r];
    { auto rr = __builtin_amdgcn_permlane32_swap(__float_as_uint(ps), __float_as_uint(ps), false, false);
      ps = __uint_as_float(rr[0]) + __uint_as_float(rr[1]); }
    l_reg = l_reg * alpha + ps;
#define PK4(P, B_, OUT) do { unsigned a0 = cvt_pk_bf16(P[B_+0], P[B_+1]), a1 = cvt_pk_bf16(P[B_+2], P[B_+3]);                          \
        unsigned b0 = cvt_pk_bf16(P[B_+4], P[B_+5]), b1 = cvt_pk_bf16(P[B_+6], P[B_+7]);                                             \
        auto r0 = __builtin_amdgcn_permlane32_swap(a0, b0, false, false); auto r1 = __builtin_amdgcn_permlane32_swap(a1, b1, false, false); \
        u32x4 w = {r0[0], r1[0], r0[1], r1[1]}; OUT = __builtin_bit_cast(bf16x8, w); } while (0)
    PK4(p0, 0, pa0); PK4(p0, 8, pa1); PK4(p1, 0, pa2); PK4(p1, 8, pa3);
#undef PK4
}
template <int DK, int KB>
__device__ __forceinline__ void qkt(f32x16& p0, f32x16& p1, const LAS unsigned char* K_lds, int r32, int hi, const bf16x8* qr) {
    constexpr int KROW = DK * 2, SHM_K = 64 * KROW;
    p0 = f32x16{}; p1 = f32x16{};
    const LAS unsigned char* kb[4];
#pragma unroll
    for (int dd = 0; dd < 4; ++dd) kb[dd] = K_lds + KB * SHM_K + r32 * KROW + (((dd * 16 + hi * 8) * 2) ^ ((r32 & 7) << 4));
#pragma unroll
    for (int d0 = 0; d0 < DK / 16; ++d0) { const LAS unsigned char* a = kb[d0 & 3] + (d0 >> 2) * 128;
        const bf16x8 b0 = *(const LAS bf16x8*)a;
        const bf16x8 b1 = *(const LAS bf16x8*)(a + 32 * KROW);
        p0 = __builtin_amdgcn_mfma_f32_32x32x16_bf16(b0, qr[d0], p0, 0, 0, 0);
        p1 = __builtin_amdgcn_mfma_f32_32x32x16_bf16(b1, qr[d0], p1, 0, 0, 0); }
}
template <int VB>
__device__ __forceinline__ void pv_tile(f32x16* o, int vb0, bf16x8 pa0, bf16x8 pa1, bf16x8 pa2, bf16x8 pa3) {
#define TRRD(dst, off) asm volatile("ds_read_b64_tr_b16 %0, %1 offset:%2" : "=&v"(dst) : "v"(vb0), "i"(off) : "memory")
#define PV_D0(d0) do { s16x4 l0, l1, l2, l3, h0, h1, h2, h3; constexpr int b_ = VB * SHM_V + v_rd_off(d0, 0, 0); \
        TRRD(l0, b_); TRRD(h0, b_ + 2048); TRRD(l1, b_ + 4096); TRRD(h1, b_ + 6144); TRRD(l2, b_ + 8192); TRRD(h2, b_ + 10240); TRRD(l3, b_ + 12288); TRRD(h3, b_ + 14336); \
        asm volatile("s_waitcnt lgkmcnt(0)" ::: "memory"); __builtin_amdgcn_sched_barrier(0);   \
        o[d0] = __builtin_amdgcn_mfma_f32_32x32x16_bf16(pa0, (bf16x8){l0[0], l0[1], l0[2], l0[3], h0[0], h0[1], h0[2], h0[3]}, o[d0], 0, 0, 0);   \
        o[d0] = __builtin_amdgcn_mfma_f32_32x32x16_bf16(pa1, (bf16x8){l1[0], l1[1], l1[2], l1[3], h1[0], h1[1], h1[2], h1[3]}, o[d0], 0, 0, 0);   \
        o[d0] = __builtin_amdgcn_mfma_f32_32x32x16_bf16(pa2, (bf16x8){l2[0], l2[1], l2[2], l2[3], h2[0], h2[1], h2[2], h2[3]}, o[d0], 0, 0, 0);   \
        o[d0] = __builtin_amdgcn_mfma_f32_32x32x16_bf16(pa3, (bf16x8){l3[0], l3[1], l3[2], l3[3], h3[0], h3[1], h3[2], h3[3]}, o[d0], 0, 0, 0); } while (0)
    PV_D0(0); PV_D0(1); PV_D0(2); PV_D0(3);
#undef PV_D0
#undef TRRD
}
template <int DK, bool CAUSAL>
__device__ __forceinline__ void attn_block(LAS unsigned char* lds, const bf16* Q, int qp, const bf16* Kn, int kp, const bf16* Kr, const bf16* V, int vp,
                                           bf16* O, int op, float* part, int P0, int NT) {
    constexpr int KROW = DK * 2, SHM_K = 64 * KROW, ND = DK / 16, NKP = SHM_K / 8192;
    const int tid = threadIdx.x, wid = __builtin_amdgcn_readfirstlane(tid >> 6), lane = tid & 63, r32 = lane & 31, hi = lane >> 5;
    LAS unsigned char* V_lds = lds; LAS unsigned char* K_lds = lds + 2 * SHM_V;
    LAS float* ws = (LAS float*)(lds + 2 * SHM_V + 2 * SHM_K) + wid * 64; LAS float* li_l = ws; LAS float* al_l = ws + 32;
    bf16x8 qr[ND];
#pragma unroll
    for (int d0 = 0; d0 < ND; ++d0) qr[d0] = *(const bf16x8*)(Q + (size_t)(wid * 32 + r32) * qp + d0 * 16 + hi * 8);
    unsigned koff[NKP], voff[2]; bool krope[NKP];
#pragma unroll
    for (int i = 0; i < NKP; ++i) { const int p = (wid * NKP + i) * 1024 + lane * 16, row = p / KROW, cpos = p - row * KROW, x = (row & 7) << 4;
        krope[i] = (DK == 192) && cpos >= 256;
        koff[i] = krope[i] ? (unsigned)(row * 128 + ((cpos - 256) ^ x)) : (unsigned)(row * kp * 2 + (cpos ^ x)); }
#pragma unroll
    for (int i = 0; i < 2; ++i) { const int p = (wid * 2 + i) * 1024 + lane * 16, sub = p >> 9, kk = (sub >> 2) * 8 + ((p & 511) >> 6), cc = (p & 63) >> 1;
        const int k = (kk & ~0xC) | ((kk & 4) << 1) | ((kk & 8) >> 1), c = (sub & 3) * 32 + cc;
        voff[i] = (unsigned)(k * vp * 2 + c * 2); }
    const int vb0 = (int)(unsigned)(uintptr_t)V_lds + v_rd_base(lane);
    const int qlo = P0 + wid * 32, qm = qlo + r32 - 4 * hi;
    float m_reg = -1e30f, l_reg = 0.f; f32x16 o[4] = {};
    f32x16 p0, p1; float mn, alpha; bf16x8 pa0, pa1, pa2, pa3;
#define AT_DMA(k0, bf) do { \
        _Pragma("unroll") for (int i_ = 0; i_ < NKP; ++i_) { const char* s_ = krope[i_] ? (const char*)Kr + (size_t)(k0) * 128 + koff[i_] : (const char*)Kn + (size_t)(k0) * kp * 2 + koff[i_]; \
            __builtin_amdgcn_global_load_lds((const unsigned*)s_, (LAS unsigned*)(K_lds + (bf) * SHM_K + (wid * NKP + i_) * 1024), 16, 0, 0); } \
        _Pragma("unroll") for (int i_ = 0; i_ < 2; ++i_) { const char* s_ = (const char*)V + (size_t)(k0) * vp * 2 + voff[i_]; \
            __builtin_amdgcn_global_load_lds((const unsigned*)s_, (LAS unsigned*)(V_lds + (bf) * SHM_V + (wid * 2 + i_) * 1024), 16, 0, 0); } } while (0)
#define AT_RESC(a) do { if (__any((a) < 1.f)) { if (hi == 0) al_l[r32] = (a); asm volatile("s_waitcnt lgkmcnt(0)" ::: "memory"); \
        _Pragma("unroll") for (int d_ = 0; d_ < 4; ++d_) _Pragma("unroll") for (int r = 0; r < 16; ++r) o[d_][r] *= al_l[crow(r, hi)]; } } while (0)
#define AT_STEP(t, B) do { asm volatile("s_waitcnt vmcnt(0)" ::: "memory"); __syncthreads(); \
        if ((t) + 1 < NT) AT_DMA(((t) + 1) * 64, 1 - (B)); \
        qkt<DK, B>(p0, p1, K_lds, r32, hi, qr); \
        if (CAUSAL) { const int kb_ = (t) * 64; if (kb_ + 63 > qlo) mask_tile(p0, p1, qm - kb_); } \
        partialSM<DK>(p0, p1, m_reg, mn, alpha); AT_RESC(alpha); finishSM(p0, p1, alpha, l_reg, pa0, pa1, pa2, pa3); __builtin_amdgcn_sched_barrier(0); \
        pv_tile<B>(o, vb0, pa0, pa1, pa2, pa3); } while (0)
    AT_DMA(0, 0);
    for (int t = 0; t < NT; t += 2) { AT_STEP(t, 0); AT_STEP(t + 1, 1); }
    if (hi == 0) li_l[r32] = l_reg; asm volatile("s_waitcnt lgkmcnt(0)" ::: "memory");
    bf16* Ow = O + (size_t)(wid * 32) * op; float* pw = part + wid * 32;
#pragma unroll
    for (int r = 0; r < 16; ++r) { const int orow = crow(r, hi); const float rli = __builtin_amdgcn_rcpf(li_l[orow]); float sq = 0.f;
#pragma unroll
        for (int d0 = 0; d0 < 4; ++d0) { const float v = o[d0][r] * rli; sq += v * v; const float vn = __shfl_xor(v, 1);
            if ((r32 & 1) == 0) *(unsigned*)(Ow + (size_t)orow * op + d0 * 32 + r32) = cvt_pk_bf16(v, vn); }
        sq += __shfl_xor(sq, 1); sq += __shfl_xor(sq, 2); sq += __shfl_xor(sq, 4); sq += __shfl_xor(sq, 8); sq += __shfl_xor(sq, 16);
        if (r32 == 0) pw[orow] = sq; }
    asm volatile("s_waitcnt vmcnt(0)" ::: "memory"); __syncthreads();
#undef AT_DMA
#undef AT_RESC
#undef AT_STEP
}
}

#define XB_TMO      128
#define XB_XCNT(j)  (256  + 64 * (j))
#define XB_XSUB(j)  (1280 + 64 * (j))
#define XB_XGEN(j)  (2304 + 64 * (j))
#define XB_TOP      3328
#define XB_TOPGEN   3392
#define XCD_BAR_WORDS 3456
#define XB_SPIN_CAP (1u << 18)
__device__ __forceinline__ unsigned xb_ld(unsigned* p)              { return __hip_atomic_load(p, __ATOMIC_RELAXED, __HIP_MEMORY_SCOPE_AGENT); }
__device__ __forceinline__ unsigned xb_add(unsigned* p, unsigned v) { return __hip_atomic_fetch_add(p, v, __ATOMIC_RELAXED, __HIP_MEMORY_SCOPE_AGENT); }
__device__ __forceinline__ unsigned xb_xcc_id() { return (unsigned)__builtin_amdgcn_s_getreg((3 << 11) | 20) & 0xFu; }
#define XB_SPIN(cond, bar) do { unsigned _sp = 0; while (cond) { __builtin_amdgcn_s_sleep(1); \
    if ((++_sp & 255u) == 0u) { if (xb_ld(&(bar)[XB_TMO])) break; if (_sp > XB_SPIN_CAP) { atomicAdd(&(bar)[XB_TMO], 1u); break; } } } } while (0)
struct XcdBarrier { unsigned* bar; unsigned x; volatile LAS unsigned* st; unsigned total; };
__device__ __forceinline__ XcdBarrier xcd_barrier_post(unsigned* bar, volatile LAS unsigned* st, unsigned total) {
    XcdBarrier b; b.bar = bar; b.x = xb_xcc_id(); b.st = st; b.total = total;
    if (threadIdx.x == 0) (void)xb_add(&bar[XB_XCNT(b.x)], 1u);
    return b;
}
__device__ __forceinline__ void xcd_barrier_complete(unsigned* bar, unsigned x, unsigned& nloc, unsigned& nx, const unsigned G) {
    unsigned sum, cnt, mine, sp = 0u;
    for (;;) {
        sum = 0u; cnt = 0u; mine = 0u;
#pragma unroll
        for (unsigned j = 0; j < 16; ++j) { const unsigned c = xb_ld(&bar[XB_XCNT(j)]); sum += c; cnt += (c > 0u) ? 1u : 0u; mine = (j == x) ? c : mine; }
        if (sum == G) break;
        __builtin_amdgcn_s_sleep(1);
        if ((++sp & 255u) == 0u) { if (xb_ld(&bar[XB_TMO])) break; if (sp > XB_SPIN_CAP) { atomicAdd(&bar[XB_TMO], 1u); break; } }
    }
    nloc = mine > 0u ? mine : 1u; nx = cnt > 0u ? cnt : 1u;
}
__device__ __forceinline__ void xcd_barrier(const XcdBarrier& b) {
    asm volatile("s_waitcnt vmcnt(0)" ::: "memory");
    __syncthreads();
    if (threadIdx.x == 0) {
        unsigned* bar = b.bar;
        __builtin_amdgcn_s_waitcnt(0);
        unsigned nloc = b.st[0], nx = b.st[1];
        if (nloc == 0u) { xcd_barrier_complete(bar, b.x, nloc, nx, b.total); b.st[0] = nloc; b.st[1] = nx; }
        const unsigned old = xb_add(&bar[XB_XSUB(b.x)], 1u);
        const unsigned gen = old / nloc;
        if (old + 1u == (gen + 1u) * nloc) {
            __builtin_amdgcn_fence(__ATOMIC_RELEASE, "agent");
            asm volatile("s_waitcnt vmcnt(0)" ::: "memory");
            const unsigned og = xb_add(&bar[XB_TOP], 1u);
            const unsigned tg = og / nx;
            if (og + 1u == (tg + 1u) * nx) xb_add(&bar[XB_TOPGEN], 1u);
            else XB_SPIN(xb_ld(&bar[XB_TOPGEN]) == tg, bar);
            __builtin_amdgcn_fence(__ATOMIC_ACQUIRE, "agent");
            xb_add(&bar[XB_XGEN(b.x)], 1u);
            asm volatile("s_waitcnt vmcnt(0)" ::: "memory");
        } else {
            XB_SPIN(xb_ld(&bar[XB_XGEN(b.x)]) == gen, bar);
            __builtin_amdgcn_fence(__ATOMIC_ACQUIRE, "agent");
            asm volatile("s_waitcnt vmcnt(0)" ::: "memory");
        }
    }
    __syncthreads();
}

struct InP { const LAS unsigned long long* T;
    __device__ __forceinline__ const float* operator[](int k) const { const unsigned long long v = T[k];
        const unsigned lo = __builtin_amdgcn_readfirstlane((unsigned)v), hi = __builtin_amdgcn_readfirstlane((unsigned)(v >> 32));
        return (const float*)(GAS const float*)(((unsigned long long)hi << 32) | lo); } };
__device__ __forceinline__ float tr_kgain(const InP& a, int mode, int k) {
    switch (mode) {
        case 0: return a[3][k];
        case 1: return a[16][k];
        case 2: return a[5][k];
        case 3: return a[7][k];
        case 4: return k < 1024 ? a[20][k] : (k < 1536 ? a[21][k - 1024] : a[22][k - 1536]);
        case 5: return a[24][k];
        default: return 1.0f;
    }
}
__device__ __forceinline__ void tr_mapn(const InP& a, int mode, int n, int& r, float& cg) {
    cg = 1.0f; r = n;
    switch (mode) {
        case 0:
            if (n < 1024) { r = n; }
            else if (n < 1088) { const int i = n - 1024; r = 2560 + (i < 32 ? i : 128 + (i - 32)); cg = a[12][i]; }
            else if (n < 2112) { r = 1024 + (n - 1088); }
            else { const int j = n - 2112; r = 2048 + j; cg = a[18][j & 127]; }
            break;
        case 1: if (n < 512) cg = a[19][n & 127]; break;
        case 2: { const int h = n / 192, d = n - h * 192;
            if (d < 128) { r = h * 128 + d; cg = a[9][d]; }
            else { const int i = d - 128; r = 1024 + (h >> 2) * 256 + (i < 32 ? 0 : 128) + (h & 3) * 32 + (i & 31); cg = a[10][i]; } } break;
        case 3: { const int h = n >> 8, d = n & 255;
            if (d < 128) { r = h * 128 + d; cg = a[11][d]; } else { r = 1024 + h * 128 + (d - 128); } } break;
        case 5: if (n < 2048) r = (n >> 7) * 256 + (n & 127); else { const int j = n - 2048; r = (j >> 7) * 256 + 128 + (j & 127); } break;
        default: break;
    }
}
__device__ __forceinline__ void tr_item(const InP& a, const float* W, int K, int N, bf16* WT, int mode, LAS float* scr, int item, int lane) {
    const int nblk = N >> 6, kb = item / nblk, nb = item - kb * nblk, k0 = kb << 6, n0 = nb << 6;
#pragma unroll 4
    for (int i = 0; i < 16; ++i) { const int kk = 4 * i + (lane >> 4), nn = (lane & 15) * 4;
        const f32x4 v = *(const f32x4*)(W + (size_t)(k0 + kk) * N + n0 + nn) * tr_kgain(a, mode, k0 + kk);
        LAS float* s = scr + kk * 65 + nn; s[0] = v[0]; s[1] = v[1]; s[2] = v[2]; s[3] = v[3]; }
    asm volatile("s_waitcnt lgkmcnt(0)" ::: "memory");
    const int c = lane & 7;
#pragma unroll
    for (int j = 0; j < 8; ++j) { const int n = (lane >> 3) + 8 * j; int r; float cg; tr_mapn(a, mode, n0 + n, r, cg);
        const LAS float* s = scr + (8 * c) * 65 + n;
        u32x4 o; o.x = cvt_pk_bf16(s[0] * cg, s[65] * cg); o.y = cvt_pk_bf16(s[130] * cg, s[195] * cg); o.z = cvt_pk_bf16(s[260] * cg, s[325] * cg); o.w = cvt_pk_bf16(s[390] * cg, s[455] * cg);
        *(u32x4*)(WT + (size_t)r * K + k0 + 8 * c) = o; }
    asm volatile("s_waitcnt lgkmcnt(0)" ::: "memory");
}
template <int MODE> __device__ __forceinline__ void tr8w_all(const float* Wsrc, unsigned char* Wdst, const float* gain, LAS unsigned char* lds, int bid, int G, int wave, int lane) {
    constexpr int N = MODE == 5 ? 4096 : 2048, NTN = N / 256, PER = 16 * NTN, NIT = 32 * PER, PITCH = 144, BUFB = 256 * PITCH;
    f32x4 vA[16], vB[16];
    int it = bid; if (it >= NIT) return;
#define TR8W_DECODE(IT, WB, OP, K0, N0) const int e_ = (IT) / PER, r_ = (IT) - e_ * PER, K0 = (r_ / NTN) * 128, N0 = (r_ % NTN) * 256; \
        const float* WB = Wsrc + (size_t)e_ * 2048 * N + (size_t)(K0 + 16 * wave) * N + N0; unsigned char* OP = Wdst + (size_t)e_ * N * 2048 + (size_t)(K0 >> 7) * 32768;
    const unsigned voff = (unsigned)lane * 16u;
#define TR8W_LOAD(V, IT) do { const int itc_ = (IT) < NIT ? (IT) : NIT - 1; TR8W_DECODE(itc_, wb_, op_, k0_, n0_); (void)op_; (void)n0_; (void)k0_; \
        _Pragma("unroll") for (int i = 0; i < 16; ++i) { const float* b_ = wb_ + (size_t)i * N; \
            asm volatile("global_load_dwordx4 %0, %1, %2 nt" : "=v"(V[i]) : "v"(voff), "s"(b_) : "memory"); } } while (0)
#define TR8W_WAIT(V) do { if (first) { if (&V[0] == &vA[0]) asm volatile("s_waitcnt vmcnt(16)" ::: "memory"); else asm volatile("s_waitcnt vmcnt(20)" ::: "memory"); } \
        else asm volatile("s_waitcnt vmcnt(24)" ::: "memory");                \
        _Pragma("unroll") for (int i = 0; i < 16; ++i) asm volatile("" : "+v"(V[i])); } while (0)
#define TR8W_PROC(V, IT, PAR) do { TR8W_DECODE(IT, wb, op, k0, n0); (void)wb; \
        unsigned pk[16]; (void)k0; (void)gain;                                 \
        TR8W_WAIT(V); \
        _Pragma("unroll") for (int i = 0; i < 16; ++i) { const f32x4 w = V[i] * 32.0f; \
            int t = __builtin_amdgcn_cvt_pk_fp8_f32(w[0], w[1], 0, false); t = __builtin_amdgcn_cvt_pk_fp8_f32(w[2], w[3], t, true); pk[i] = (unsigned)t; } \
        _Pragma("unroll") for (int i = 0; i < 16; ++i) asm volatile("" : "+v"(pk[i]));     \
        TR8W_LOAD(V, (IT) + 2 * G);                                           \
        u32x4 c[4]; \
        _Pragma("unroll") for (int bq = 0; bq < 4; ++bq) { const unsigned r0 = pk[4 * bq], r1 = pk[4 * bq + 1], r2 = pk[4 * bq + 2], r3 = pk[4 * bq + 3]; \
            const unsigned t0 = __builtin_amdgcn_perm(r1, r0, 0x05010400u), t1 = __builtin_amdgcn_perm(r1, r0, 0x07030602u); \
            const unsigned t2 = __builtin_amdgcn_perm(r3, r2, 0x05010400u), t3 = __builtin_amdgcn_perm(r3, r2, 0x07030602u); \
            c[0][bq] = __builtin_amdgcn_perm(t2, t0, 0x05040100u); c[1][bq] = __builtin_amdgcn_perm(t2, t0, 0x07060302u); \
            c[2][bq] = __builtin_amdgcn_perm(t3, t1, 0x05040100u); c[3][bq] = __builtin_amdgcn_perm(t3, t1, 0x07060302u); } \
        LAS unsigned char* T = lds + (PAR) * BUFB; \
        _Pragma("unroll") for (int j = 0; j < 4; ++j) *(LAS u32x4*)(T + (j * 64 + lane) * PITCH + 16 * wave) = c[j];     \
        asm volatile("s_waitcnt lgkmcnt(0)" ::: "memory"); __builtin_amdgcn_s_barrier(); asm volatile("" ::: "memory"); \
        _Pragma("unroll") for (int q = 0; q < 4; ++q) { const int slot = 32 * wave + 8 * q + (lane >> 3), ch = lane & 7, n = n0 + 4 * (slot & 63) + (slot >> 6); \
            const int r = (MODE == 5) ? (n < 2048 ? (n >> 7) * 256 + (n & 127) : ((n - 2048) >> 7) * 256 + 128 + ((n - 2048) & 127)) : n; \
            const u32x4 w = *(const LAS u32x4*)(T + slot * PITCH + 16 * ch); \
            __builtin_nontemporal_store(w, (u32x4*)(op + (size_t)(r >> 8) * 524288 + (size_t)(r & 255) * 128 + 16 * ch)); } } while (0)
    bool first = true;
    TR8W_LOAD(vA, it); TR8W_LOAD(vB, it + G);
    for (;;) {
        TR8W_PROC(vA, it, 0);
        if (it + G >= NIT) break;
        TR8W_PROC(vB, it + G, 1);
        if (it + 2 * G >= NIT) break;
        it += 2 * G; first = false;
    }
    asm volatile("s_waitcnt vmcnt(0)" ::: "memory");
#pragma unroll
    for (int i = 0; i < 16; ++i) asm volatile("" :: "v"(vA[i]), "v"(vB[i]));
    asm volatile("s_waitcnt lgkmcnt(0)" ::: "memory"); __builtin_amdgcn_s_barrier();
#undef TR8W_DECODE
#undef TR8W_LOAD
#undef TR8W_WAIT
#undef TR8W_PROC
}
__device__ __forceinline__ void row_cvt(const float* xrow, bf16* orow, float* rs, int lane) {
    const f32x4* xr = (const f32x4*)xrow + lane; f32x4 v[8]; float s = 0.f;
#pragma unroll
    for (int j = 0; j < 8; ++j) { v[j] = xr[64 * j]; s += dot4(v[j]); }
    s = wave_sum(s);
    if (lane == 0) *rs = rsqrtf(s * (1.0f / 2048.0f) + EPS);
    u32x2* o8 = (u32x2*)orow + lane;
#pragma unroll
    for (int j = 0; j < 8; ++j) { u32x2 w; w.x = cvt_pk_bf16(v[j][0], v[j][1]); w.y = cvt_pk_bf16(v[j][2], v[j][3]); o8[64 * j] = w; }
}

__device__ __forceinline__ void row_cvt2(const float* x0, const float* x1, bf16* o0, bf16* o1, float* rs0, float* rs1, int lane) {
    const f32x4* xa = (const f32x4*)x0 + lane; const f32x4* xb = (const f32x4*)x1 + lane; f32x4 va[8], vb[8]; float sa = 0.f, sb = 0.f;
#pragma unroll
    for (int j = 0; j < 8; ++j) va[j] = __builtin_nontemporal_load(xa + 64 * j);
#pragma unroll
    for (int j = 0; j < 8; ++j) vb[j] = __builtin_nontemporal_load(xb + 64 * j);
#pragma unroll
    for (int j = 0; j < 8; ++j) sa += dot4(va[j]);
#pragma unroll
    for (int j = 0; j < 8; ++j) sb += dot4(vb[j]);
    sa = wave_sum(sa); sb = wave_sum(sb);
    if (lane == 0) { *rs0 = rsqrtf(sa * (1.0f / 2048.0f) + EPS); *rs1 = rsqrtf(sb * (1.0f / 2048.0f) + EPS); }
    u32x2* pa = (u32x2*)o0 + lane; u32x2* pb = (u32x2*)o1 + lane;
#pragma unroll
    for (int j = 0; j < 8; ++j) { u32x2 w; w.x = cvt_pk_bf16(va[j][0], va[j][1]); w.y = cvt_pk_bf16(va[j][2], va[j][3]); pa[64 * j] = w; }
#pragma unroll
    for (int j = 0; j < 8; ++j) { u32x2 w; w.x = cvt_pk_bf16(vb[j][0], vb[j][1]); w.y = cvt_pk_bf16(vb[j][2], vb[j][3]); pb[64 * j] = w; }
}

__global__ void __launch_bounds__(512, 2) fwd_kernel(Args args) {
    extern __shared__ __attribute__((aligned(16))) unsigned char lds_raw[];
    LAS unsigned char* lds = (LAS unsigned char*)lds_raw;
    const int tid = threadIdx.x, lane = tid & 63, wave = __builtin_amdgcn_readfirstlane(tid >> 6);
    const int G = gridDim.x, bid = blockIdx.x;
    unsigned* ctl = (unsigned*)(GAS unsigned*)(args.ws + WS_CTL);
    GAS unsigned char* wsg = (GAS unsigned char*)args.ws;
#define wsp ((unsigned char*)wsg)
#define LAUNDER_WS() asm volatile("" : "+s"(wsg))
#define W1T ((bf16*)(wsp + WS_W1T))
#define WMKVT ((bf16*)(wsp + WS_WMKVT))
#define WQBT ((bf16*)(wsp + WS_WQBT))
#define WKVBT ((bf16*)(wsp + WS_WKVBT))
#define WOT ((bf16*)(wsp + WS_WOT))
#define WSP ((bf16*)(wsp + WS_WSP))
#define WR4 ((float*)(wsp + WS_WR4))
#define WGUT ((unsigned char*)(wsp + WS_WGUT))
#define WDT ((unsigned char*)(wsp + WS_WDT))
#define XB ((bf16*)(wsp + WS_XB))
#define MEMB ((bf16*)(wsp + WS_MEMB))
#define RSTDX ((float*)(wsp + WS_RSTDX))
#define RSTDM ((float*)(wsp + WS_RSTDM))
#define ROPEC ((float*)(wsp + WS_ROPEC))
#define ROPES ((float*)(wsp + WS_ROPES))
#define CQ ((bf16*)(wsp + WS_CQ))
#define CKV ((bf16*)(wsp + WS_CKV))
#define U ((bf16*)(wsp + WS_U))
#define VG ((bf16*)(wsp + WS_VG))
#define QM ((bf16*)(wsp + WS_QM))
#define KPE ((bf16*)(wsp + WS_KPE))
#define MK ((bf16*)(wsp + WS_MK))
#define MV ((bf16*)(wsp + WS_MV))
#define PARTQ ((float*)(wsp + WS_PARTQ))
#define PARTKV ((float*)(wsp + WS_PARTKV))
#define PARTVG ((float*)(wsp + WS_PARTVG))
#define PARTA ((float*)(wsp + WS_PARTA))
#define PARTB ((float*)(wsp + WS_PARTB))
#define PARTM ((float*)(wsp + WS_PARTM))
#define PARTF ((float*)(wsp + WS_PARTF))
#define QBUF ((bf16*)(wsp + WS_QBUF))
#define KBUF ((bf16*)(wsp + WS_KBUF))
#define VBUF ((bf16*)(wsp + WS_VBUF))
#define OC ((bf16*)(wsp + WS_OC))
#define XQ1 ((unsigned char*)(wsp + WS_XB1))
#define LTOK ((int*)(wsp + WS_LTOK))
#define LRS ((float*)(wsp + WS_LRS))
#define LGATE ((float*)(wsp + WS_LGATE))
#define SEL ((int*)(wsp + WS_SEL))
#define ACT ((unsigned char*)(wsp + WS_ACT))
#define Y ((unsigned char*)(wsp + WS_Y))
    float* X1 = (float*)(GAS float*)args.out;

    for (int u = tid; u < 64; u += 512) ((LAS unsigned*)(lds + MISC_OFF))[u] = 0u;
    if (tid < 31) ((LAS unsigned long long*)(lds + PT_OFF))[tid] = (unsigned long long)args.in[tid];
    __syncthreads();
    const InP INP{(const LAS unsigned long long*)(lds + PT_OFF)};
    const int NCONV = (G == 256) ? 64 : 0;
    const bool is_conv = NCONV != 0 && ((bid >> 3) & 3) == 3;
    const int Gc = G - NCONV, cidx = NCONV ? (bid >> 5) * 24 + (bid & 31) : bid, vidx = (bid >> 5) * 8 + (bid & 7);
    XcdBarrier bar = xcd_barrier_post(ctl + CW_BAR, (volatile LAS unsigned*)(lds + MISC_OFF) + 8, (unsigned)G);
    XcdBarrier barc = bar;
    if (NCONV && !is_conv) barc = xcd_barrier_post(ctl + CW_BAR + XCD_BAR_WORDS, (volatile LAS unsigned*)(lds + MISC_OFF) + 12, (unsigned)Gc);
    const int lo = args.ph_lo, hi = args.ph_hi;
#ifndef PHASE_MASK
#define PHASE_MASK 0x1ff
#endif
#define IN(k) (((PHASE_MASK >> (k)) & 1) && lo <= (k) && (k) < hi)
#define SEAM(k) do { if (IN(k) && IN((k) + 1)) { if (NCONV && (k) >= 1 && (k) <= 3) { if (!is_conv) xcd_barrier(barc); } else xcd_barrier(bar); } } while (0)

    if (IN(0)) REPS(0) {
        LAUNDER_WS();
        LAS float* scr = (LAS float*)(lds + wave * 16640);
        const int gw = bid * 8 + wave, NGW = G * 8;
        if (!NCONV) { tr8w_all<5>(INP[27], WGUT, INP[24], lds, bid, G, wave, lane); tr8w_all<6>(INP[29], WDT, INP[24], lds, bid, G, wave, lane); }
        for (int it = gw; it < 1312 + 512 + 192 + 256 + 1024; it += NGW) {
            int r = it;
            if (r < 1312) { tr_item(INP, INP[4], 2048, 2624, W1T, 0, scr, r, lane); continue; } r -= 1312;
            if (r < 512) { tr_item(INP, INP[17], 2048, 1024, WMKVT, 1, scr, r, lane); continue; } r -= 512;
            if (r < 192) { tr_item(INP, INP[6], 512, 1536, WQBT, 2, scr, r, lane); continue; } r -= 192;
            if (r < 256) { tr_item(INP, INP[8], 512, 2048, WKVBT, 3, scr, r, lane); continue; } r -= 256;
            tr_item(INP, INP[23], 2048, 2048, WOT, 4, scr, r, lane);
        }
        for (int it = gw; it < 192; it += NGW) { const int rr = it < 96 ? 32 + it : 160 + (it - 96); u32x4* p = (u32x4*)(W1T + (size_t)(2560 + rr) * 2048) + lane;
#pragma unroll
            for (int j = 0; j < 4; ++j) p[64 * j] = (u32x4){0u, 0u, 0u, 0u}; }
        for (int m = gw; m < NTOK; m += 2 * NGW) {
            if (m + NGW < NTOK) row_cvt2(INP[0] + (size_t)m * 2048, INP[0] + (size_t)(m + NGW) * 2048, XB + (size_t)m * 2048, XB + (size_t)(m + NGW) * 2048, RSTDX + m, RSTDX + m + NGW, lane);
            else row_cvt(INP[0] + (size_t)m * 2048, XB + (size_t)m * 2048, RSTDX + m, lane); }
        for (int m = gw; m < NMROWS; m += NGW) row_cvt(INP[1] + (size_t)m * 2048, MEMB + (size_t)m * 2048, RSTDM + m, lane);
        const int gt = bid * 512 + tid, NGT = G * 512;
        for (int i = gt; i < NTOK * 32; i += NGT) { const int tok = i >> 5, j = i & 31; const float ang = (float)((const int*)INP[2])[tok] * args.invf[j];
            float sn, cs; sincosf(ang, &sn, &cs); ROPEC[i] = cs; ROPES[i] = sn; }
        for (int i = gt; i < 4 * 128 * 128; i += NGT) { const int t = (i >> 7) & 127, s = i & 127; const float w = s <= t ? INP[14][i] : 0.f; WSP[i] = (bf16)(cvt_pk_bf16(w, 0.f) & 0xffffu); }
        for (int i = gt; i < 2048 * 32; i += NGT) { const int k = i >> 5, n = i & 31; const float w = INP[25][i] * INP[24][k]; const unsigned hb = cvt_pk_bf16(w, 0.f) & 0xffffu, lb = cvt_pk_bf16(w - __uint_as_float(hb << 16), 0.f) & 0xffffu;
            const int o = (((k >> 4) * 2 + ((k >> 3) & 1)) * 32 + n) * 8 + (k & 7); ((unsigned short*)WR4)[o] = (unsigned short)hb; ((unsigned short*)WR4)[65536 + o] = (unsigned short)lb; }
    }
    SEAM(0);

    if (IN(1) && is_conv) {
        LAUNDER_WS();
        tr8w_all<5>(INP[27], WGUT, INP[24], lds, vidx, NCONV, wave, lane); tr8w_all<6>(INP[29], WDT, INP[24], lds, vidx, NCONV, wave, lane);
    }
    if (IN(1) && !is_conv) REPS(1) {
        LAUNDER_WS();
        Sched1 S{Gc, cidx, XB, W1T, MEMB, WMKVT};
        Epi1 E{RSTDX, RSTDM, ROPEC, ROPES, CQ, CKV, U, VG, QM, KPE, MK, MV, PARTQ, PARTKV, PARTVG};
        pg8::gemm_phase<Epi1, Sched1, false, false>(lds, 32, 4096, 128, 4096, 128, S, E);
    }
    SEAM(1);

    if (IN(2) && !is_conv) REPS(2) {
        LAUNDER_WS();
#ifndef P2_PARTS
#define P2_PARTS 7
#endif
        if (P2_PARTS & 1) { Sched2 S{Gc, cidx, CQ, CKV, WQBT, WKVBT};
          Epi2 E{PARTQ, PARTKV, ROPEC, ROPES, QBUF, KBUF, VBUF};
          pg8::gemm_phase<Epi2, Sched2, false, false>(lds, 8, 1024, 128, 1024, 128, S, E); }
        if (P2_PARTS & 2) {
            LAS unsigned short* T = (LAS unsigned short*)lds;
            LAS float* rsl = (LAS float*)(lds + 40960);
            const int wq = wave & 3, tb = (wave >> 2) * 64, fr = lane & 15, fq = lane >> 4;
            const int p4 = tid & 31, cch = tid >> 5;
            for (int unit = Gc - 1 - cidx; unit < 512; unit += Gc) {
                const int g = unit & 3, cn = unit >> 2, row0 = cn * 128;
                u32x4 vr[4];
#pragma unroll
                for (int r = 0; r < 4; ++r) vr[r] = *(const u32x4*)(VG + (size_t)(row0 + 4 * p4 + r) * 512 + g * 128 + 8 * cch);
                bf16x8 af[4][4];
#pragma unroll
                for (int ks = 0; ks < 4; ++ks)
#pragma unroll
                    for (int m = 0; m < 4; ++m) af[ks][m] = *(const bf16x8*)(WSP + (size_t)(g * 128 + tb + 16 * m + fr) * 128 + ks * 32 + 8 * fq);
                u32x2 uw[4][2]; float bs[4]; f32x4 gv[2];
#pragma unroll
                for (int m = 0; m < 4; ++m) { bs[m] = INP[15][g * 128 + tb + 16 * m + fr];
#pragma unroll
                    for (int n = 0; n < 2; ++n) uw[m][n] = *(const u32x2*)(U + (size_t)(row0 + tb + 16 * m + fr) * 512 + g * 128 + wq * 32 + 16 * n + 4 * fq); }
#pragma unroll
                for (int n = 0; n < 2; ++n) gv[n] = *(const f32x4*)(INP[13] + g * 128 + wq * 32 + 16 * n + 4 * fq);
                if (tid < 128) { float s = 0.f;
#pragma unroll
                    for (int k = 0; k < 8; ++k) s += PARTVG[(size_t)k * NTOK + row0 + tid];
                    rsl[tid] = rsqrtf(s * (1.0f / 512.0f) + EPS); }
                __syncthreads();
                { const f32x4 rs = *(const LAS f32x4*)(rsl + 4 * p4); unsigned nw[4][4];
#pragma unroll
                  for (int r = 0; r < 4; ++r)
#pragma unroll
                    for (int j = 0; j < 4; ++j) { const unsigned x = vr[r][j]; nw[r][j] = cvt_pk_bf16(__uint_as_float(x << 16) * rs[r], __uint_as_float(x & 0xffff0000u) * rs[r]); }
#pragma unroll
                  for (int j = 0; j < 4; ++j) {
                    u32x2 lo, hi;
                    lo.x = __builtin_amdgcn_perm(nw[1][j], nw[0][j], 0x05040100u); lo.y = __builtin_amdgcn_perm(nw[3][j], nw[2][j], 0x05040100u);
                    hi.x = __builtin_amdgcn_perm(nw[1][j], nw[0][j], 0x07060302u); hi.y = __builtin_amdgcn_perm(nw[3][j], nw[2][j], 0x07060302u);
                    *(LAS u32x2*)(T + (8 * cch + 2 * j) * 136 + 4 * p4) = lo; *(LAS u32x2*)(T + (8 * cch + 2 * j + 1) * 136 + 4 * p4) = hi; } }
                __syncthreads();
                f32x4 acc[4][2];
#pragma unroll
                for (int m = 0; m < 4; ++m) { acc[m][0] = (f32x4){0.f, 0.f, 0.f, 0.f}; acc[m][1] = (f32x4){0.f, 0.f, 0.f, 0.f}; }
#pragma unroll
                for (int ks = 0; ks < 4; ++ks) {
                    bf16x8 bfr[2];
#pragma unroll
                    for (int n = 0; n < 2; ++n) bfr[n] = *(const LAS bf16x8*)(T + (wq * 32 + 16 * n + fr) * 136 + ks * 32 + 8 * fq);
#pragma unroll
                    for (int m = 0; m < 4; ++m)
#pragma unroll
                        for (int n = 0; n < 2; ++n) acc[m][n] = __builtin_amdgcn_mfma_f32_16x16x32_bf16(bfr[n], af[ks][m], acc[m][n], 0, 0, 0);
                }
#pragma unroll
                for (int m = 0; m < 4; ++m) { const int t = tb + 16 * m + fr, row = row0 + t; float ss = 0.f;
#pragma unroll
                    for (int n = 0; n < 2; ++n) { const int c = g * 128 + wq * 32 + 16 * n + 4 * fq;
                        const u32x2 w2 = uw[m][n];
                        const f32x4 uv = {__uint_as_float(w2.x << 16), __uint_as_float(w2.x & 0xffff0000u), __uint_as_float(w2.y << 16), __uint_as_float(w2.y & 0xffff0000u)};
                        const f32x4 ov = uv * (acc[m][n] * gv[n] + bs[m]); ss += dot4(ov);
                        u32x2 w; w.x = cvt_pk_bf16(ov[0], ov[1]); w.y = cvt_pk_bf16(ov[2], ov[3]); *(u32x2*)(OC + (size_t)row * 2048 + 1024 + c) = w; }
                    ss = red4(ss); if (fq == 0) PARTB[(size_t)(g * 4 + wq) * NTOK + row] = ss; }
                __syncthreads();
            }
        }
        if (P2_PARTS & 4) for (int it = Gc - 1 - cidx; it < 256; it += Gc) {
            const int bh = (it & 7) * 2 + ((it >> 3) >> 4), qb = (it >> 3) & 15, b = bh >> 2, h = bh & 3; const size_t r0 = (size_t)b * SEQ + qb * 256;
            att::attn_block<128, false>(lds, QM + r0 * 512 + h * 128, 512, MK + (size_t)b * NMEM * 512 + h * 128, 512, nullptr, MV + (size_t)b * NMEM * 512 + h * 128, 512,
                                        OC + r0 * 2048 + 1536 + h * 128, 2048, PARTM + (size_t)h * NTOK + r0, 0, 4);
        }
    }
    SEAM(2);

    if (IN(3) && !is_conv) REPS(3) {
        LAUNDER_WS();
        unsigned pat; int nblk;
        if (Gc == 192) { const int p = cidx >> 5;
            pat = p == 0 ? 0x23Fu : p == 1 ? 0x7Eu : p == 2 ? 0x8Du : p == 3 ? 0x9Cu : p == 4 ? 0xABu : 0x01456u;
            nblk = p == 0 ? 3 : p == 5 ? 5 : 2; }
        else { pat = 0u; nblk = (512 + Gc - 1) / Gc; }
#pragma unroll 1
        for (int r = 0; r < nblk; ++r) {
            int qb, bh;
            if (Gc == 192) { qb = (int)((pat >> (4 * r)) & 15u); bh = cidx & 31; }
            else { const int i = r * Gc + ((r & 1) ? Gc - 1 - cidx : cidx); if (i >= 512) continue; qb = 15 - (i >> 5); bh = i & 31; }
            const int b = bh >> 3, h = bh & 7; const size_t r0 = (size_t)b * SEQ + qb * 256;
            att::attn_block<192, true>(lds, QBUF + r0 * 1536 + h * 192, 1536, KBUF + (size_t)b * SEQ * 1024 + h * 128, 1024, KPE + (size_t)b * SEQ * 64,
                                       VBUF + (size_t)b * SEQ * 1024 + h * 128, 1024, OC + r0 * 2048 + h * 128, 2048, PARTA + (size_t)h * NTOK + r0, qb * 256, qb * 4 + 4);
        }
    }
    SEAM(3);

    if (IN(4) && !is_conv) REPS(4) {
        LAUNDER_WS();
        Sched4 S{Gc, cidx, OC, WOT};
        Epi4 E{PARTA, PARTB, PARTM, INP[24], XB, PARTF, XQ1};
        pg8::gemm_phase<Epi4, Sched4, false, false>(lds, 32, 4096, 128, 4096, 128, S, E);
    }
    SEAM(4);

    if (IN(5) && DBG_LAST_PHASE >= 5) {
        LAUNDER_WS();
        LAS float* LG = (LAS float*)lds;
        LAS int* hist = (LAS int*)(lds + 69632); LAS int* base = hist + 32;
        const int r32 = lane & 31, hi5 = lane >> 5, kq = wave;
        for (int ch = bid; ch < NTOK / 64; ch += G) {
            const int tok0 = ch * 64;
            if (tid < 32) hist[tid] = 0;
            float ssum = 0.f, rbias[32];
            if (tid < 64) {
#pragma unroll
                for (int k = 0; k < 32; ++k) ssum += PARTF[(size_t)k * NTOK + tok0 + tid];
#pragma unroll
                for (int e = 0; e < 32; ++e) rbias[e] = INP[26][e];
            } else {
#pragma unroll
                for (int e = 0; e < 32; ++e) rbias[e] = 0.f;
            }
            f32x16 acc0 = {}, acc1 = {};
            const bf16* xp = XB + (size_t)(tok0 + r32) * 2048 + kq * 256 + 8 * hi5;
            const bf16* wh = (const bf16*)WR4 + ((size_t)(kq * 16 * 2 + hi5) * 32 + r32) * 8; const bf16* wl = wh + 65536;
#pragma unroll 4
            for (int s = 0; s < 16; ++s) { const bf16x8 a0 = *(const bf16x8*)(xp + 16 * s), a1 = *(const bf16x8*)(xp + 32 * 2048 + 16 * s), bh = *(const bf16x8*)(wh + (size_t)s * 512), bl = *(const bf16x8*)(wl + (size_t)s * 512);
                acc0 = __builtin_amdgcn_mfma_f32_32x32x16_bf16(a0, bh, acc0, 0, 0, 0); acc1 = __builtin_amdgcn_mfma_f32_32x32x16_bf16(a1, bh, acc1, 0, 0, 0);
                acc0 = __builtin_amdgcn_mfma_f32_32x32x16_bf16(a0, bl, acc0, 0, 0, 0); acc1 = __builtin_amdgcn_mfma_f32_32x32x16_bf16(a1, bl, acc1, 0, 0, 0); }
#pragma unroll
            for (int r = 0; r < 16; ++r) { LG[(kq * 64 + att::crow(r, hi5)) * 33 + r32] = acc0[r]; LG[(kq * 64 + 32 + att::crow(r, hi5)) * 33 + r32] = acc1[r]; }
            __syncthreads();
            int se[4] = {0, 0, 0, 0}, sl[4] = {0, 0, 0, 0}; float gate[4] = {0.f, 0.f, 0.f, 0.f}, rs2 = 0.f;
            if (tid < 64) {
                const int tl = tid;
                rs2 = rsqrtf(ssum * (1.0f / 2048.0f) + EPS);
                float v[32];
#pragma unroll
                for (int e = 0; e < 32; ++e) { float s = 0.f;
#pragma unroll
                    for (int q = 0; q < 8; ++q) s += LG[(q * 64 + tl) * 33 + e];
                    v[e] = s * rs2 + rbias[e]; }
                float tv[4];
#pragma unroll
                for (int k = 0; k < 4; ++k) { float best = -__builtin_inff(); int bi = 0;
#pragma unroll
                    for (int e = 0; e < 32; ++e) if (v[e] > best) { best = v[e]; bi = e; }
#pragma unroll
                    for (int e = 0; e < 32; ++e) v[e] = (e == bi) ? -__builtin_inff() : v[e];
                    se[k] = bi; tv[k] = best; }
                float den = 0.f;
#pragma unroll
                for (int k = 0; k < 4; ++k) { gate[k] = __expf(tv[k] - tv[0]); den += gate[k]; }
                const float inv = 1.0f / den;
#pragma unroll
                for (int k = 0; k < 4; ++k) { gate[k] *= inv; sl[k] = __hip_atomic_fetch_add(hist + se[k], 1, __ATOMIC_RELAXED, __HIP_MEMORY_SCOPE_WORKGROUP); }
            }
            __syncthreads();
            if (tid < 32) { const int hcnt = hist[tid]; base[tid] = hcnt > 0 ? (int)__hip_atomic_fetch_add(ctl + CW_CNT + 64 * tid, (unsigned)hcnt, __ATOMIC_RELAXED, __HIP_MEMORY_SCOPE_AGENT) : 0; }
            __syncthreads();
            if (tid < 64) { const int tok = tok0 + tid;
#pragma unroll
                for (int k = 0; k < 4; ++k) { const int e = se[k], slot = base[e] + sl[k]; LTOK[e * LCAP + slot] = tok; LRS[e * LCAP + slot] = rs2; LGATE[e * LCAP + slot] = gate[k]; SEL[tok * 4 + k] = e * LCAP + slot; } }
            __syncthreads();
        }
    }
    SEAM(5);

#define MOE_TABLES() do { LAS int* T_ = (LAS int*)(lds + MOE_OFF); if (tid < 64) { const int e_ = lane & 31; \
        const int c_ = (int)__hip_atomic_load(ctl + CW_CNT + 64 * e_, __ATOMIC_RELAXED, __HIP_MEMORY_SCOPE_AGENT); int nt_ = (c_ + 255) >> 8, inc_ = nt_; \
        _Pragma("unroll") for (int o_ = 1; o_ < 32; o_ <<= 1) { const int v_ = __shfl_up(inc_, o_); if (e_ >= o_) inc_ += v_; } \
        if (tid < 32) { T_[e_ + 1] = inc_; T_[64 + e_] = (inc_ - nt_) * 256; T_[128 + e_] = c_; if (e_ == 0) T_[0] = 0; } } __syncthreads(); } while (0)

    if (IN(6) && DBG_LAST_PHASE >= 6) REPS(6) {
        LAUNDER_WS();
        MOE_TABLES();
        SchedM<true> S{G, bid, (const LAS int*)(lds + MOE_OFF), XQ1, WGUT, LTOK};
        Epi6 E{LRS, INP[28], ACT};
        pg8::gemm_phase<Epi6, SchedM<true>, true, true>(lds, 16, 2048, 128, 128, 32768, S, E);
    }
    SEAM(6);

    if (IN(7) && DBG_LAST_PHASE >= 7) REPS(7) {
        LAUNDER_WS();
        MOE_TABLES();
        SchedM<false> S{G, bid, (const LAS int*)(lds + MOE_OFF), ACT, WDT, LTOK};
        Epi7 E{LGATE, INP[30], Y};
        pg8::gemm_phase<Epi7, SchedM<false>, true, true>(lds, 16, 128, 32768, 128, 32768, S, E);
    }
    SEAM(7);

    if (IN(8) && DBG_LAST_PHASE >= 8) {
        LAUNDER_WS();
        MOE_TABLES();
        const LAS int* T = (const LAS int*)(lds + MOE_OFF);
        const int gw = bid * 8 + wave, NGW = G * 8;
        for (int tok = gw; tok < NTOK; tok += NGW) {
            const int4 sel = *(const int4*)(SEL + tok * 4); size_t yr[4];
            yr[0] = (size_t)(T[64 + (sel.x >> 14)] + (sel.x & (LCAP - 1))) * 2048; yr[1] = (size_t)(T[64 + (sel.y >> 14)] + (sel.y & (LCAP - 1))) * 2048;
            yr[2] = (size_t)(T[64 + (sel.z >> 14)] + (sel.z & (LCAP - 1))) * 2048; yr[3] = (size_t)(T[64 + (sel.w >> 14)] + (sel.w & (LCAP - 1))) * 2048;
            u32x4 yw[2][4], xw[2][2];
#pragma unroll
            for (int j = 0; j < 2; ++j) {
#pragma unroll
                for (int k = 0; k < 4; ++k) yw[j][k] = *((const u32x4*)(Y + yr[k] + 1024 * j) + lane);
#pragma unroll
                for (int q = 0; q < 2; ++q) xw[j][q] = *((const u32x4*)(XB + (size_t)tok * 2048 + 1024 * j + 16 * lane) + q); }
#pragma unroll
            for (int j = 0; j < 2; ++j)
#pragma unroll
                for (int q = 0; q < 4; ++q) { const unsigned x01 = xw[j][q >> 1][(q & 1) * 2], x23 = xw[j][q >> 1][(q & 1) * 2 + 1];
                    f32x4 v = {__uint_as_float(x01 << 16), __uint_as_float(x01 & 0xffff0000u), __uint_as_float(x23 << 16), __uint_as_float(x23 & 0xffff0000u)};
#pragma unroll
                    for (int k = 0; k < 4; ++k) { const int w = (int)yw[j][k][q];
                        v += (f32x4){__builtin_amdgcn_cvt_f32_fp8(w, 0), __builtin_amdgcn_cvt_f32_fp8(w, 1), __builtin_amdgcn_cvt_f32_fp8(w, 2), __builtin_amdgcn_cvt_f32_fp8(w, 3)} * 0.0625f; }
                    *((f32x4*)(X1 + (size_t)tok * 2048 + 1024 * j + 16 * lane) + q) = v; }
        }
    }
#undef IN
#undef SEAM
#undef W1T
#undef WMKVT
#undef WQBT
#undef WKVBT
#undef WOT
#undef WSP
#undef WR4
#undef WGUT
#undef WDT
#undef XB
#undef MEMB
#undef RSTDX
#undef RSTDM
#undef ROPEC
#undef ROPES
#undef CQ
#undef CKV
#undef U
#undef VG
#undef QM
#undef KPE
#undef MK
#undef MV
#undef PARTQ
#undef PARTKV
#undef PARTVG
#undef PARTA
#undef PARTB
#undef PARTM
#undef PARTF
#undef QBUF
#undef KBUF
#undef VBUF
#undef OC
#undef XQ1
#undef LTOK
#undef LRS
#undef LGATE
#undef SEL
#undef ACT
#undef Y
}

extern "C" void kernel_launch(void* const* d_in, const int* in_sizes, int n_in, void* d_out, int out_size, void* d_ws, size_t ws_size, hipStream_t stream) {
    static int grid = 0;
    if (grid == 0) {
        if (n_in != 31 || out_size != NTOK * DM || ws_size < WS_END) { fprintf(stderr, "kernel_launch: unexpected shapes (n_in %d out %d ws %zu need %zu)\n", n_in, out_size, ws_size, (size_t)WS_END); grid = -1; return; }
        int dev = 0, cus = 0;
        if (hipGetDevice(&dev) != hipSuccess || hipDeviceGetAttribute(&cus, hipDeviceAttributeMultiprocessorCount, dev) != hipSuccess) { grid = -1; return; }
        if (hipFuncSetAttribute((const void*)fwd_kernel, hipFuncAttributeMaxDynamicSharedMemorySize, LDS_BYTES) != hipSuccess) { fprintf(stderr, "kernel_launch: hipFuncSetAttribute failed\n"); grid = -1; return; }
        int per_cu = 0;
        if (hipOccupancyMaxActiveBlocksPerMultiprocessor(&per_cu, (const void*)fwd_kernel, 512, LDS_BYTES) != hipSuccess || per_cu < 1) { fprintf(stderr, "kernel_launch: occupancy query says %d\n", per_cu); }
        (void)hipGetLastError();
        grid = cus > 0 ? cus : 256;
    }
    if (grid < 0) return;
    (void)hipMemsetAsync((char*)d_ws + WS_CTL, 0, CTL_BYTES, stream);
    Args a{};
    for (int i = 0; i < 31; ++i) a.in[i] = (const float*)d_in[i];
    a.out = (float*)d_out; a.ws = (unsigned char*)d_ws;
    for (int i = 0; i < 32; ++i) a.invf[i] = powf(10000.0f, -(float)i / 32.0f);
#if MK_N_LAUNCHES == 1
    a.ph_lo = 0; a.ph_hi = NPHASE;
    hipLaunchKernelGGL(fwd_kernel, dim3(grid), dim3(512), LDS_BYTES, stream, a);
#else
    for (int p = 0; p < NPHASE; ++p) { a.ph_lo = p; a.ph_hi = p + 1; hipLaunchKernelGGL(fwd_kernel, dim3(grid), dim3(512), LDS_BYTES, stream, a); }
#endif
}
```
